# Optimizing an MI355X kernel written in HIP

```python
import jax, jax.numpy as jnp
from jax import lax
import numpy as np

D_MODEL = 2048
BATCH = 4
SEQ = 2048
DEPTH = 2

N_BRANCH = 4
BRANCH_WIDTH = D_MODEL // 4
LRU_WIDTH = BRANCH_WIDTH
LRU_BLOCKS = 8
LRU_BLOCK_DIM = LRU_WIDTH // LRU_BLOCKS
LRU_CONV = 4
LRU_C = 8.0
POOL_WIDTH = BRANCH_WIDTH
POOL_WINDOWS = (2, 4, 8, 16)
POOL_GROUPS = 4
POOL_GROUP_DIM = POOL_WIDTH // POOL_GROUPS
SCONV_WIDTH = BRANCH_WIDTH
SCONV_K = 3
ATTN_HEADS = 8
HEAD_DIM = BRANCH_WIDTH // ATTN_HEADS
ATTN_WIDTH = ATTN_HEADS * HEAD_DIM
Q_BLOCK = 128
D_FF = 4 * D_MODEL
EPS = 1e-6
IN_SIZES = (LRU_WIDTH, POOL_WIDTH, 3 * SCONV_WIDTH, 3 * ATTN_WIDTH, ATTN_HEADS, N_BRANCH * D_MODEL)
N_IN = sum(IN_SIZES)

kernel_name = "hybrid_gated_parallel_mixers"


def _split_points():
    return [int(v) for v in np.cumsum(IN_SIZES)[:-1]]


def rms_norm(x, g):
    xf = x.astype(jnp.float32)
    y = xf * lax.rsqrt(jnp.mean(xf * xf, axis=-1, keepdims=True) + EPS)
    return (y * g.astype(jnp.float32)).astype(x.dtype)


def causal_depthwise_conv(x, w):
    k_width = w.shape[0]
    s = x.shape[1]
    xp = jnp.pad(x, ((0, 0), (k_width - 1, 0), (0, 0)))
    return sum(w[k] * xp[:, k:k + s] for k in range(k_width))


def rglru_branch(xa, conv_w, conv_b, wr, br, wi, bi, lam):
    b, s, _ = xa.shape
    u = causal_depthwise_conv(xa, conv_w) + conv_b
    ub = u.reshape(b, s, LRU_BLOCKS, LRU_BLOCK_DIM)
    r = jax.nn.sigmoid(jnp.einsum('bshi,hij->bshj', ub, wr).reshape(b, s, LRU_WIDTH) + br)
    gi = jax.nn.sigmoid(jnp.einsum('bshi,hij->bshj', ub, wi).reshape(b, s, LRU_WIDTH) + bi)
    log_a = (-LRU_C * r.astype(jnp.float32)) * jax.nn.softplus(-lam.astype(jnp.float32))
    a = jnp.exp(log_a)
    inp = jnp.sqrt(-jnp.expm1(2.0 * log_a)) * (gi * u).astype(jnp.float32)

    def combine(c1, c2):
        a1, b1 = c1
        a2, b2 = c2
        return a1 * a2, a2 * b1 + b2

    _, h = lax.associative_scan(combine, (a, inp), axis=1)
    return h.astype(xa.dtype)


def pool_branch(xp, w_grp, scale):
    b, s, _ = xp.shape
    xf = xp.astype(jnp.float32)
    csum = jnp.pad(jnp.cumsum(xf, axis=1), ((0, 0), (1, 0), (0, 0)))
    t = jnp.arange(s)
    outs = []
    for gidx, win in enumerate(POOL_WINDOWS):
        sl = slice(gidx * POOL_GROUP_DIM, (gidx + 1) * POOL_GROUP_DIM)
        start = jnp.maximum(t + 1 - win, 0)
        win_sum = csum[:, 1:, sl] - csum[:, start, sl]
        count = jnp.minimum(t + 1, win).astype(jnp.float32)[None, :, None]
        outs.append(win_sum / count - xf[:, :, sl])
    pooled = jnp.stack(outs, axis=2)
    mixed = jnp.einsum('bsgi,gij->bsgj', pooled, w_grp.astype(jnp.float32)).reshape(b, s, POOL_WIDTH)
    return (mixed * scale.astype(jnp.float32)).astype(xp.dtype)


def shortconv_branch(xsc, w):
    gate_b, gate_c, xc = jnp.split(xsc, 3, axis=-1)
    return gate_b * causal_depthwise_conv(gate_c * xc, w)


def forgetting_attention(qkv, f_logit, f_bias, q_g, k_g):
    b, s, _ = qkv.shape
    q, k, v = jnp.split(qkv, 3, axis=-1)
    q = rms_norm(q.reshape(b, s, ATTN_HEADS, HEAD_DIM), q_g)
    k = rms_norm(k.reshape(b, s, ATTN_HEADS, HEAD_DIM), k_g)
    v = v.reshape(b, s, ATTN_HEADS, HEAD_DIM)
    log_f = jax.nn.log_sigmoid((f_logit + f_bias).astype(jnp.float32))
    cum = jnp.cumsum(log_f, axis=1).transpose(0, 2, 1)
    n_blk = s // Q_BLOCK
    qb = q.reshape(b, n_blk, Q_BLOCK, ATTN_HEADS, HEAD_DIM).transpose(1, 0, 2, 3, 4)
    cqb = cum.reshape(b, ATTN_HEADS, n_blk, Q_BLOCK).transpose(2, 0, 1, 3)
    key_pos = jnp.arange(s)
    scale = HEAD_DIM ** -0.5

    def one_block(args):
        qi, cqi, blk = args
        logits = jnp.einsum('bqhd,bkhd->bhqk', qi, k).astype(jnp.float32) * scale
        logits = logits + (cqi[..., :, None] - cum[..., None, :])
        q_pos = blk * Q_BLOCK + jnp.arange(Q_BLOCK)
        logits = jnp.where(key_pos[None, :] <= q_pos[:, None], logits, -jnp.inf)
        p = jax.nn.softmax(logits, axis=-1)
        return jnp.einsum('bhqk,bkhd->bqhd', p.astype(v.dtype), v)

    out = lax.map(one_block, (qb, cqb, jnp.arange(n_blk)))
    return out.transpose(1, 0, 2, 3, 4).reshape(b, s, ATTN_WIDTH)


def setup_inputs(seed: int = 0) -> dict:
    key = jax.random.key(seed)
    ks = jax.random.split(key, 24)
    L, D, W = DEPTH, D_MODEL, BRANCH_WIDTH
    nrm = lambda k, shape, fan: jax.random.normal(k, shape, jnp.float32) * (fan ** -0.5)
    u = jax.random.uniform(ks[9], (L, LRU_WIDTH), jnp.float32, 0.9, 0.999)
    a0 = u ** (1.0 / LRU_C)
    return {
        "x": jax.random.normal(ks[0], (BATCH, SEQ, D), jnp.float32),
        "norm_mix_g": 1.0 + 0.1 * jax.random.normal(ks[1], (L, D), jnp.float32),
        "w_in": nrm(ks[2], (L, D, N_IN), D),
        "lru_conv_w": nrm(ks[3], (L, LRU_CONV, LRU_WIDTH), LRU_CONV),
        "lru_conv_b": 0.02 * jax.random.normal(ks[4], (L, LRU_WIDTH), jnp.float32),
        "lru_wr": nrm(ks[5], (L, LRU_BLOCKS, LRU_BLOCK_DIM, LRU_BLOCK_DIM), LRU_BLOCK_DIM),
        "lru_br": 0.02 * jax.random.normal(ks[6], (L, LRU_WIDTH), jnp.float32),
        "lru_wi": nrm(ks[7], (L, LRU_BLOCKS, LRU_BLOCK_DIM, LRU_BLOCK_DIM), LRU_BLOCK_DIM),
        "lru_bi": 0.02 * jax.random.normal(ks[8], (L, LRU_WIDTH), jnp.float32),
        "lru_lambda": jnp.log(a0) - jnp.log1p(-a0),
        "pool_w": nrm(ks[10], (L, POOL_GROUPS, POOL_GROUP_DIM, POOL_GROUP_DIM), POOL_GROUP_DIM),
        "pool_scale": 1.0 + 0.1 * jax.random.normal(ks[11], (L, POOL_WIDTH), jnp.float32),
        "sconv_w": nrm(ks[12], (L, SCONV_K, SCONV_WIDTH), SCONV_K),
        "q_norm_g": 1.0 + 0.1 * jax.random.normal(ks[13], (L, HEAD_DIM), jnp.float32),
        "k_norm_g": 1.0 + 0.1 * jax.random.normal(ks[14], (L, HEAD_DIM), jnp.float32),
        "forget_b": jax.random.uniform(ks[15], (L, ATTN_HEADS), jnp.float32, 1.0, 5.0),
        "w_branch": nrm(ks[16], (L, N_BRANCH, W, D), W),
        "w_out": nrm(ks[17], (L, D, D), D),
        "norm_mlp_g": 1.0 + 0.1 * jax.random.normal(ks[18], (L, D), jnp.float32),
        "w_mlp_up": nrm(ks[19], (L, D, D_FF), D),
        "w_mlp_down": nrm(ks[20], (L, D_FF, D), D_FF),
    }


def reference(x, norm_mix_g, w_in, lru_conv_w, lru_conv_b, lru_wr, lru_br, lru_wi, lru_bi,
              lru_lambda, pool_w, pool_scale, sconv_w, q_norm_g, k_norm_g, forget_b,
              w_branch, w_out, norm_mlp_g, w_mlp_up, w_mlp_down):
    b, s, d = x.shape
    split_pts = _split_points()
    for l in range(DEPTH):
        xn = rms_norm(x, norm_mix_g[l])
        proj = xn @ w_in[l]
        xa, xpool, xsc, qkv, f_logit, gate_logits = jnp.split(proj, split_pts, axis=-1)
        y_a = rglru_branch(xa, lru_conv_w[l], lru_conv_b[l], lru_wr[l], lru_br[l],
                           lru_wi[l], lru_bi[l], lru_lambda[l])
        y_b = pool_branch(xpool, pool_w[l], pool_scale[l])
        y_c = shortconv_branch(xsc, sconv_w[l])
        y_d = forgetting_attention(qkv, f_logit, forget_b[l], q_norm_g[l], k_norm_g[l])
        ys = jnp.stack([y_a, y_b, y_c, y_d], axis=2)
        branches = jnp.einsum('bskw,kwd->bskd', ys, w_branch[l])
        gates = jax.nn.sigmoid(gate_logits.reshape(b, s, N_BRANCH, d))
        merged = jnp.sum(gates * branches, axis=2)
        x = x + merged @ w_out[l]
        h = rms_norm(x, norm_mlp_g[l]) @ w_mlp_up[l]
        x = x + jnp.square(jax.nn.relu(h)) @ w_mlp_down[l]
    return x
```

```cpp
#include <hip/hip_runtime.h>
#include <hip/hip_cooperative_groups.h>
#include <cstdio>
#include <cstdint>
namespace cg = cooperative_groups;

#define LAS __attribute__((address_space(3)))
typedef unsigned short bf16_t;
typedef short bf16x8 __attribute__((ext_vector_type(8)));
typedef short s16x4 __attribute__((ext_vector_type(4)));
typedef float f32x4 __attribute__((ext_vector_type(4)));
typedef unsigned u32x4 __attribute__((ext_vector_type(4)));
typedef unsigned u32x2 __attribute__((ext_vector_type(2)));

constexpr int T = 8192, SEQ = 2048, DM = 2048, NIN_SRC = 12296, NIN = 12288, DFF = 8192, NLAYER = 2;
constexpr float EPS = 1e-6f, LOG2E = 1.4426950408889634f;
constexpr size_t MiB = 1u << 20;
constexpr size_t WS_SS = 0, WS_LOGF = 1 * MiB, WS_WF = 2 * MiB, WS_WPOOL = 3 * MiB, WS_WLRU = 4 * MiB, WS_WIN = 8 * MiB, WS_WB = 104 * MiB, WS_WO = 120 * MiB,
                 WS_WUP = 136 * MiB, WS_WDN = 200 * MiB, WS_XB = 264 * MiB, WS_XRES = 296 * MiB, WS_PROJ = 360 * MiB, WS_GATES = 424 * MiB, WS_HBUF = 424 * MiB,
                 WS_YCAT = 552 * MiB, WS_MF32 = 584 * MiB, WS_MB = 648 * MiB, WS_U = 680 * MiB, WS_POOLED = 688 * MiB, WS_A = 696 * MiB, WS_INP = 712 * MiB, WS_END = 728 * MiB;
constexpr int LDS_BYTES = 147456;

__device__ __forceinline__ unsigned cvt_pk_bf16(float lo, float hi) { unsigned r; asm volatile("v_cvt_pk_bf16_f32 %0, %1, %2" : "=v"(r) : "v"(lo), "v"(hi)); return r; }
__device__ __forceinline__ float bf_lo(unsigned w) { return __builtin_bit_cast(float, w << 16); }
__device__ __forceinline__ float bf_hi(unsigned w) { return __builtin_bit_cast(float, w & 0xffff0000u); }
__device__ __forceinline__ void unpack8(u32x4 w, float (&f)[8]) { f[0] = bf_lo(w.x); f[1] = bf_hi(w.x); f[2] = bf_lo(w.y); f[3] = bf_hi(w.y); f[4] = bf_lo(w.z); f[5] = bf_hi(w.z); f[6] = bf_lo(w.w); f[7] = bf_hi(w.w); }
__device__ __forceinline__ u32x4 pack8(const float (&f)[8]) { u32x4 w; w.x = cvt_pk_bf16(f[0], f[1]); w.y = cvt_pk_bf16(f[2], f[3]); w.z = cvt_pk_bf16(f[4], f[5]); w.w = cvt_pk_bf16(f[6], f[7]); return w; }
__device__ __forceinline__ float fsigmoid(float v) { return __builtin_amdgcn_rcpf(1.f + __builtin_amdgcn_exp2f(-v * LOG2E)); }
__device__ __forceinline__ float wave_sum(float v) {
#pragma unroll
    for (int o = 1; o < 64; o <<= 1) v += __shfl_xor(v, o);
    return v;
}

namespace pg8 {
constexpr int BM = 256, BK = 64, HALF = 128, HTB = HALF * BK * 2, STAGE_BYTES = 8 * HTB, NXCD = 8, WGM = 4;
__host__ __device__ __forceinline__ int lds_byte(int r, int c) { const int st = (r >> 4) * 2 + (c >> 5), rr = r & 15, cc = c & 31, ob = rr * 64 + cc * 2; return st * 1024 + (ob ^ (((ob >> 9) & 1) << 5)); }
__host__ __device__ __forceinline__ void stage_rc(int b, int& R, int& C) { const int st = b / 1024, sb = b % 1024, swz = sb ^ (((sb >> 9) & 1) << 5); R = (st >> 1) * 16 + swz / 64; C = (st & 1) * 32 + (swz % 64) / 2; }
__host__ __device__ __forceinline__ int perm32(int rho) { const int n = rho >> 4, i = rho & 15; return 8 * (i >> 2) + 4 * n + (i & 3); }

struct Unit { int pm, pn, ks; unsigned koff; };
struct Gemm { const bf16_t* A; const bf16_t* Bt; int lda, ldb, K; };

struct StaticOrder {
    int nM, nN, nwg, G, c;
    __device__ void init(int M, int N, int G_, int c_) { nM = M / BM; nN = N / BM; nwg = nM * nN; G = G_; c = c_; }
    __device__ bool tile(int i, int& pm, int& pn) const {
        const long L = (long)i * G + c; if (L >= nwg) return false;
        int wgid = (int)L; { const int q = nwg / NXCD, r = nwg % NXCD, xcd = wgid % NXCD, off = wgid / NXCD; wgid = (xcd < r ? xcd * (q + 1) : r * (q + 1) + (xcd - r) * q) + off; }
        const int nig = WGM * nN, gid = wgid / nig, fm = gid * WGM, gsz = (nM - fm) < WGM ? (nM - fm) : WGM;
        pm = fm + ((wgid % nig) % gsz); pn = (wgid % nig) / gsz; return true;
    }
};
struct SchedStd { StaticOrder so; __device__ bool next(int i, Unit& u) const { u.ks = 0; u.koff = 0; return so.tile(i, u.pm, u.pn); } };
struct SchedSeg { StaticOrder so; int nseg; unsigned segbytes;
    __device__ bool next(int i, Unit& u) const { u.ks = i % nseg; u.koff = (unsigned)u.ks * segbytes; return so.tile(i / nseg, u.pm, u.pn); } };
struct SchedSmall { int nM, nN, G, c, cu_off; unsigned pnbytes;
    __device__ bool next(int i, Unit& u) const { const int idx = i * G + ((c - cu_off + G) % G); if (idx >= nM * nN) return false; u.pm = idx / nN; u.pn = idx % nN; u.ks = 0; u.koff = (unsigned)u.pn * pnbytes; return true; } };

typedef f32x4 AccT[2][2][4][2];

struct EpiInProj {
    static constexpr bool CARRY = false;
    const float* ss; bf16_t* proj; bf16_t* gates;
    __device__ __forceinline__ void operator()(AccT& acc, const Unit& u, int wr, int wc, int fr, int fq) const {
        const int row0 = u.pm * BM + wr * 64 + fr; const bool isg = u.pn >= 16;
        float rs[2][4];
#pragma unroll
        for (int ai = 0; ai < 2; ++ai)
#pragma unroll
            for (int m = 0; m < 4; ++m) rs[ai][m] = ss[row0 + ai * HALF + m * 16];
        if (!isg) { const int col0 = u.pn * BM + wc * 32 + 8 * fq;
#pragma unroll
            for (int ai = 0; ai < 2; ++ai)
#pragma unroll
                for (int m = 0; m < 4; ++m) { const int row = row0 + ai * HALF + m * 16; const float r = __builtin_amdgcn_rsqf(rs[ai][m] * (1.f / DM) + EPS);
#pragma unroll
                    for (int bj = 0; bj < 2; ++bj) { const f32x4 v0 = acc[ai][bj][m][0] * r, v1 = acc[ai][bj][m][1] * r;
                        u32x4 w; w.x = cvt_pk_bf16(v0[0], v0[1]); w.y = cvt_pk_bf16(v0[2], v0[3]); w.z = cvt_pk_bf16(v1[0], v1[1]); w.w = cvt_pk_bf16(v1[2], v1[3]);
                        *(u32x4*)(proj + (size_t)row * 4096 + col0 + bj * HALF) = w; } }
        } else { const int d0 = (u.pn - 16) * 64 + 16 * wc + 4 * fq;
#pragma unroll
            for (int ai = 0; ai < 2; ++ai)
#pragma unroll
                for (int m = 0; m < 4; ++m) { const int row = row0 + ai * HALF + m * 16; const float r = __builtin_amdgcn_rsqf(rs[ai][m] * (1.f / DM) + EPS);
                    f32x4 g[4], sden[4];
#pragma unroll
                    for (int k = 0; k < 4; ++k)
#pragma unroll
                        for (int i = 0; i < 4; ++i) { const float e = fminf(__builtin_amdgcn_exp2f(-(acc[ai][k >> 1][m][k & 1][i] * r) * LOG2E), 1e12f); sden[k][i] = 1.f + e; g[k][i] = __builtin_amdgcn_rcpf(sden[k][i]); }
                    bf16_t* gp = gates + (size_t)row * 8192 + d0;
#pragma unroll
                    for (int k = 0; k < 4; ++k) { f32x4 mk = g[k];
                        if (k < 3) {
#pragma unroll
                            for (int i = 0; i < 4; ++i) mk[i] *= sden[k + 1][i]; }
                        u32x2 w; w.x = cvt_pk_bf16(mk[0], mk[1]); w.y = cvt_pk_bf16(mk[2], mk[3]); *(u32x2*)(gp + k * 2048) = w; } }
        }
    }
};
struct EpiBranch {
    static constexpr bool CARRY = true;
    const bf16_t* gates; bf16_t* mb;
    __device__ __forceinline__ void operator()(AccT& acc, const Unit& u, int wr, int wc, int fr, int fq) const {
        const int row0 = u.pm * BM + wr * 64 + fr, col0 = u.pn * BM + wc * 32 + 8 * fq, ks = u.ks; const bool fin = ks == 3;
        u32x4 gc[2][4][2];
#pragma unroll
        for (int ai = 0; ai < 2; ++ai)
#pragma unroll
            for (int m = 0; m < 4; ++m)
#pragma unroll
                for (int bj = 0; bj < 2; ++bj) gc[ai][m][bj] = *(const u32x4*)(gates + (size_t)(row0 + ai * HALF + m * 16) * 8192 + ks * 2048 + col0 + bj * HALF);
#pragma unroll
        for (int ai = 0; ai < 2; ++ai)
#pragma unroll
            for (int m = 0; m < 4; ++m)
#pragma unroll
                for (int bj = 0; bj < 2; ++bj) { float g[8]; unpack8(gc[ai][m][bj], g);
                    f32x4 v0 = acc[ai][bj][m][0], v1 = acc[ai][bj][m][1];
                    v0[0] *= g[0]; v0[1] *= g[1]; v0[2] *= g[2]; v0[3] *= g[3]; v1[0] *= g[4]; v1[1] *= g[5]; v1[2] *= g[6]; v1[3] *= g[7];
                    acc[ai][bj][m][0] = v0; acc[ai][bj][m][1] = v1;
                    if (fin) { u32x4 w; w.x = cvt_pk_bf16(v0[0], v0[1]); w.y = cvt_pk_bf16(v0[2], v0[3]); w.z = cvt_pk_bf16(v1[0], v1[1]); w.w = cvt_pk_bf16(v1[2], v1[3]);
                        *(u32x4*)(mb + (size_t)(row0 + ai * HALF + m * 16) * DM + col0 + bj * HALF) = w; } }
    }
};
struct EpiResid {
    static constexpr bool CARRY = false;
    bf16_t* xb; float* ss; float* outf; const float* ssin;
    __device__ __forceinline__ void operator()(AccT& acc, const Unit& u, int wr, int wc, int fr, int fq) const {
        const int row0 = u.pm * BM + wr * 64 + fr, col0 = u.pn * BM + wc * 32 + 8 * fq;
#pragma unroll
        for (int ai = 0; ai < 2; ++ai) {
            u32x4 xi[4][2]; float sc[4];
#pragma unroll
            for (int m = 0; m < 4; ++m) { sc[m] = ssin ? ssin[row0 + ai * HALF + m * 16] : 0.f;
#pragma unroll
                for (int bj = 0; bj < 2; ++bj) xi[m][bj] = *(const u32x4*)(xb + (size_t)(row0 + ai * HALF + m * 16) * DM + col0 + bj * HALF); }
#pragma unroll
            for (int m = 0; m < 4; ++m) { const int row = row0 + ai * HALF + m * 16; float s = 0.f; const float f = ssin ? __builtin_amdgcn_rcpf(sc[m] * (1.f / DM) + EPS) : 1.f;
#pragma unroll
                for (int bj = 0; bj < 2; ++bj) { const size_t off = (size_t)row * DM + col0 + bj * HALF; float xv[8]; unpack8(xi[m][bj], xv);
                    const f32x4 v0 = acc[ai][bj][m][0] * f + (f32x4){xv[0], xv[1], xv[2], xv[3]}, v1 = acc[ai][bj][m][1] * f + (f32x4){xv[4], xv[5], xv[6], xv[7]};
                    if (outf) { *(f32x4*)(outf + off) = v0; *(f32x4*)(outf + off + 4) = v1; }
                    else { u32x4 w; w.x = cvt_pk_bf16(v0[0], v0[1]); w.y = cvt_pk_bf16(v0[2], v0[3]); w.z = cvt_pk_bf16(v1[0], v1[1]); w.w = cvt_pk_bf16(v1[2], v1[3]);
                        *(u32x4*)(xb + off) = w;
                        s += (v0[0] * v0[0] + v0[1] * v0[1]) + (v0[2] * v0[2] + v0[3] * v0[3]) + (v1[0] * v1[0] + v1[1] * v1[1]) + (v1[2] * v1[2] + v1[3] * v1[3]); } }
                if (!outf) { s += __shfl_xor(s, 16); s += __shfl_xor(s, 32); if (fq == 0) atomicAdd(ss + row, s); } }
        }
    }
};
struct EpiUp {
    static constexpr bool CARRY = false;
    bf16_t* hb;
    __device__ __forceinline__ void operator()(AccT& acc, const Unit& u, int wr, int wc, int fr, int fq) const {
        const int row0 = u.pm * BM + wr * 64 + fr, col0 = u.pn * BM + wc * 32 + 8 * fq;
#pragma unroll
        for (int ai = 0; ai < 2; ++ai)
#pragma unroll
            for (int m = 0; m < 4; ++m) { const int row = row0 + ai * HALF + m * 16;
#pragma unroll
                for (int bj = 0; bj < 2; ++bj) { f32x4 v0 = acc[ai][bj][m][0], v1 = acc[ai][bj][m][1];
#pragma unroll
                    for (int j = 0; j < 4; ++j) { const float a = fmaxf(v0[j], 0.f), b = fmaxf(v1[j], 0.f); v0[j] = a * a; v1[j] = b * b; }
                    u32x4 w; w.x = cvt_pk_bf16(v0[0], v0[1]); w.y = cvt_pk_bf16(v0[2], v0[3]); w.z = cvt_pk_bf16(v1[0], v1[1]); w.w = cvt_pk_bf16(v1[2], v1[3]);
                    *(u32x4*)(hb + (size_t)row * DFF + col0 + bj * HALF) = w; } }
    }
};
struct EpiPool {
    static constexpr bool CARRY = false;
    const float* scale; bf16_t* ycat;
    __device__ __forceinline__ void operator()(AccT& acc, const Unit& u, int wr, int wc, int fr, int fq) const {
        const int row0 = u.pm * BM + wr * 64 + fr, col0 = u.pn * BM + wc * 32 + 8 * fq;
#pragma unroll
        for (int bj = 0; bj < 2; ++bj) { const int col = col0 + bj * HALF; const f32x4 s0 = *(const f32x4*)(scale + col), s1 = *(const f32x4*)(scale + col + 4);
#pragma unroll
            for (int ai = 0; ai < 2; ++ai)
#pragma unroll
                for (int m = 0; m < 4; ++m) { const int row = row0 + ai * HALF + m * 16; const f32x4 v0 = acc[ai][bj][m][0] * s0, v1 = acc[ai][bj][m][1] * s1;
                    u32x4 w; w.x = cvt_pk_bf16(v0[0], v0[1]); w.y = cvt_pk_bf16(v0[2], v0[3]); w.z = cvt_pk_bf16(v1[0], v1[1]); w.w = cvt_pk_bf16(v1[2], v1[3]);
                    *(u32x4*)(ycat + (size_t)row * DM + 512 + col) = w; } }
    }
};
struct EpiLru {
    static constexpr bool CARRY = false;
    const float* br; const float* bi; const bf16_t* ub; float* ab; float* ib;
    __device__ __forceinline__ void operator()(AccT& acc, const Unit& u, int wr, int wc, int fr, int fq) const {
        const int row0 = u.pm * BM + wr * 64 + fr;
#pragma unroll
        for (int n = 0; n < 2; ++n) { const int ch0 = u.pn * 128 + wc * 32 + 8 * fq + 4 * n;
            const f32x4 brv = *(const f32x4*)(br + ch0), biv = *(const f32x4*)(bi + ch0);
            u32x2 uws[2][4];
#pragma unroll
            for (int ai = 0; ai < 2; ++ai)
#pragma unroll
                for (int m = 0; m < 4; ++m) uws[ai][m] = *(const u32x2*)(ub + (size_t)(row0 + ai * HALF + m * 16) * 512 + ch0);
#pragma unroll
            for (int ai = 0; ai < 2; ++ai)
#pragma unroll
                for (int m = 0; m < 4; ++m) { const int row = row0 + ai * HALF + m * 16;
                    const u32x2 uw = uws[ai][m]; const f32x4 uu = (f32x4){bf_lo(uw.x), bf_hi(uw.x), bf_lo(uw.y), bf_hi(uw.y)};
                    f32x4 av, iv;
#pragma unroll
                    for (int j = 0; j < 4; ++j) { av[j] = fsigmoid(acc[ai][0][m][n][j] + brv[j]); iv[j] = fsigmoid(acc[ai][1][m][n][j] + biv[j]) * uu[j]; }
                    *(f32x4*)(ab + (size_t)row * 512 + ch0) = av; *(f32x4*)(ib + (size_t)row * 512 + ch0) = iv; } }
    }
};

template <class Epi, class Sched>
__device__ __forceinline__ void gemm_phase(LAS unsigned char* lds, const Gemm g, const Sched& S, const Epi& E) {
    int tid_ = threadIdx.x; asm volatile("" : "+v"(tid_));
    const int tid = tid_, wid = __builtin_amdgcn_readfirstlane(tid >> 6), lane = tid & 63, wr = wid >> 2, wc = wid & 3, fr = lane & 15, fq = lane >> 4;
    int K_ = g.K; asm volatile("" : "+s"(K_)); const int nt = K_ / BK;
    unsigned voffA, voffB;
    { int R, C; stage_rc(tid * 16, R, C); const int Rb = (R & ~31) + perm32(R & 31); voffA = (unsigned)(R * g.lda + C) * 2u; voffB = (unsigned)(Rb * g.ldb + C) * 2u; }
    const unsigned qoffA = 64u * (unsigned)g.lda * 2u, qoffB = 64u * (unsigned)g.ldb * 2u;
    const size_t kstep = (size_t)(BK * 2);
    const size_t hstepA = (size_t)HALF * g.lda * 2, hstepB = (size_t)HALF * g.ldb * 2, tstepA = 2 * hstepA, tstepB = 2 * hstepB;
    const unsigned ldsw = (unsigned)wid * 1024u;
    const int aoff = lds_byte(wr * 64 + fr, fq * 8), boff = lds_byte(wc * 32 + fr, fq * 8);
#define PG8_SA(b, h) (((b) * 2 + (h)) * HTB)
#define PG8_SB(b, h) ((4 + (b) * 2 + (h)) * HTB)
#define PG8_STAGE(bufoff, gbase, voff) do { _Pragma("unroll") for (int _i = 0; _i < 2; ++_i) \
        __builtin_amdgcn_global_load_lds((const unsigned*)((const char*)(gbase) + (size_t)(_i * q##voff) + (v##voff)), (LAS unsigned*)(lds + (bufoff) + ldsw + _i * 8192), 16, 0, 0); } while (0)
#define PG8_LDA(dst, b, h) do { _Pragma("unroll") for (int m = 0; m < 4; ++m) _Pragma("unroll") for (int k = 0; k < 2; ++k) dst[m][k] = *(const LAS bf16x8*)(lds + PG8_SA(b, h) + aoff + m * 2048 + k * 1024); } while (0)
#define PG8_LDB(dst, b, h) do { _Pragma("unroll") for (int n = 0; n < 2; ++n) _Pragma("unroll") for (int k = 0; k < 2; ++k) dst[n][k] = *(const LAS bf16x8*)(lds + PG8_SB(b, h) + boff + n * 2048 + k * 1024); } while (0)
#define PG8_MMA(ai, bj, At, Bt) do { __builtin_amdgcn_s_setprio(1); _Pragma("unroll") for (int m = 0; m < 4; ++m) _Pragma("unroll") for (int n = 0; n < 2; ++n) _Pragma("unroll") for (int k = 0; k < 2; ++k) \
        acc[ai][bj][m][n] = __builtin_amdgcn_mfma_f32_16x16x32_bf16(Bt[n][k], At[m][k], acc[ai][bj][m][n], 0, 0, 0); __builtin_amdgcn_s_setprio(0); } while (0)
#define PG8_WAIT_V(n) asm volatile("s_waitcnt vmcnt(" #n ")" ::: "memory")
#define PG8_WAIT_L(n) asm volatile("s_waitcnt lgkmcnt(" #n ")" ::: "memory")
#define PG8_BAR __builtin_amdgcn_s_barrier()
#define PG8_SCHED __builtin_amdgcn_sched_barrier(0)
    Unit cur, nxt; int ui = 0;
    if (!S.next(0, cur)) return;
    f32x4 acc[2][2][4][2];
#pragma unroll
    for (int a = 0; a < 2; ++a)
#pragma unroll
        for (int b = 0; b < 2; ++b)
#pragma unroll
            for (int m = 0; m < 4; ++m)
#pragma unroll
                for (int n = 0; n < 2; ++n) acc[a][b][m][n] = (f32x4){0.f, 0.f, 0.f, 0.f};
    bf16x8 At[4][2], B0[2][2], B1[2][2];
    const char* cA = (const char*)g.A + (size_t)cur.pm * tstepA + cur.koff; const char* cB = (const char*)g.Bt + (size_t)cur.pn * tstepB + cur.koff;
    PG8_STAGE(PG8_SB(0, 0), cB, offB); PG8_STAGE(PG8_SB(0, 1), cB + hstepB, offB); PG8_STAGE(PG8_SA(0, 0), cA, offA); PG8_STAGE(PG8_SA(0, 1), cA + hstepA, offA);
    if (wr == 1) PG8_BAR;
    PG8_WAIT_V(2); PG8_BAR;
    PG8_STAGE(PG8_SB(1, 0), cB + kstep, offB); PG8_STAGE(PG8_SA(1, 0), cA + kstep, offA); PG8_STAGE(PG8_SB(1, 1), cB + hstepB + kstep, offB);
    PG8_WAIT_V(6); PG8_BAR;
    for (;;) {
        const bool has_next = S.next(ui + 1, nxt);
        const char* nA = has_next ? (const char*)g.A + (size_t)nxt.pm * tstepA + nxt.koff : cA; const char* nB = has_next ? (const char*)g.Bt + (size_t)nxt.pn * tstepB + nxt.koff : cB;
        for (int t = 0; t < nt; t += 2) {
            const bool last = (t == nt - 2);
            const char* a1 = cA + (size_t)(t + 1) * kstep;
            const char* a2 = last ? nA : cA + (size_t)(t + 2) * kstep; const char* b2 = last ? nB : cB + (size_t)(t + 2) * kstep;
            const char* a3 = a2 + kstep; const char* b3 = b2 + kstep;
            PG8_LDB(B0, 0, 0); PG8_LDB(B1, 0, 1); PG8_SCHED; PG8_LDA(At, 0, 0); PG8_STAGE(PG8_SA(1, 1), a1 + hstepA, offA);
            PG8_WAIT_V(8); PG8_WAIT_L(0); PG8_BAR; PG8_MMA(0, 0, At, B0); PG8_MMA(0, 1, At, B1); PG8_BAR; PG8_SCHED;
            PG8_LDA(At, 0, 1); PG8_STAGE(PG8_SB(0, 0), b2, offB); PG8_STAGE(PG8_SB(0, 1), b2 + hstepB, offB); PG8_STAGE(PG8_SA(0, 0), a2, offA);
            PG8_WAIT_V(8); PG8_WAIT_L(0); PG8_BAR; PG8_MMA(1, 0, At, B0); PG8_MMA(1, 1, At, B1); PG8_BAR; PG8_SCHED;
            PG8_LDB(B0, 1, 0); PG8_LDB(B1, 1, 1); PG8_SCHED; PG8_LDA(At, 1, 0); PG8_STAGE(PG8_SA(0, 1), a2 + hstepA, offA);
            PG8_WAIT_V(8); PG8_WAIT_L(0); PG8_BAR; PG8_MMA(0, 0, At, B0); PG8_MMA(0, 1, At, B1); PG8_BAR; PG8_SCHED;
            PG8_LDA(At, 1, 1); PG8_STAGE(PG8_SB(1, 0), b3, offB); PG8_STAGE(PG8_SB(1, 1), b3 + hstepB, offB); PG8_STAGE(PG8_SA(1, 0), a3, offA);
            PG8_WAIT_V(8); PG8_WAIT_L(0); PG8_BAR; PG8_MMA(1, 0, At, B0); PG8_MMA(1, 1, At, B1); PG8_BAR; PG8_SCHED;
        }
        if (wr == 0) PG8_BAR;
        E(acc, cur, wr, wc, fr, fq);
        if (!has_next) break;
        if (!(Epi::CARRY && cur.ks != 3)) {
#pragma unroll
        for (int a = 0; a < 2; ++a)
#pragma unroll
            for (int b = 0; b < 2; ++b)
#pragma unroll
                for (int m = 0; m < 4; ++m)
#pragma unroll
                    for (int n = 0; n < 2; ++n) acc[a][b][m][n] = (f32x4){0.f, 0.f, 0.f, 0.f}; }
        cur = nxt; cA = nA; cB = nB; ++ui;
        if (wr == 1) PG8_BAR;
    }
    PG8_WAIT_V(0);
    PG8_BAR;
#undef PG8_SA
#undef PG8_SB
#undef PG8_STAGE
#undef PG8_LDA
#undef PG8_LDB
#undef PG8_MMA
#undef PG8_WAIT_V
#undef PG8_WAIT_L
#undef PG8_BAR
#undef PG8_SCHED
}
}

#define LDS_WAIT() asm volatile("s_waitcnt lgkmcnt(0)" ::: "memory")
struct TrItem { const float* W; const float* gk; bf16_t* WT; int ldw, ldt, gperm; };
__device__ __forceinline__ void tr_load(const TrItem& I, f32x4 (&v)[8][2], int lane) {
    const int c = lane & 15, rp = lane >> 4;
#pragma unroll
    for (int i = 0; i < 8; ++i) { const int r = 4 * i + rp; v[i][0] = __builtin_nontemporal_load((const f32x4*)(I.W + (size_t)(2 * r) * I.ldw + 4 * c)); v[i][1] = __builtin_nontemporal_load((const f32x4*)(I.W + (size_t)(2 * r + 1) * I.ldw + 4 * c)); }
}
__device__ __forceinline__ void tr_finish(const TrItem& I, const f32x4 (&v)[8][2], LAS unsigned* scr, int lane) {
    const int c = lane & 15, rp = lane >> 4;
#pragma unroll
    for (int i = 0; i < 8; ++i) { const int r = 4 * i + rp; float g0 = 1.f, g1 = 1.f; if (I.gk) { g0 = I.gk[2 * r]; g1 = I.gk[2 * r + 1]; }
#pragma unroll
        for (int j = 0; j < 4; ++j) scr[(4 * c + j) * 33 + r] = cvt_pk_bf16(v[i][0][j] * g0, v[i][1][j] * g1); }
    LDS_WAIT(); asm volatile("" ::: "memory");
#pragma unroll
    for (int i = 0; i < 8; ++i) { const int n = 8 * i + (lane >> 3), q = lane & 7; const LAS unsigned* sp = scr + n * 33 + 4 * q;
        const int nr = I.gperm < 0 ? n : 128 * (I.gperm >> 1) + 32 * ((n >> 4) & 3) + 8 * ((n >> 2) & 3) + 4 * (I.gperm & 1) + (n & 3);
        u32x4 o; o.x = sp[0]; o.y = sp[1]; o.z = sp[2]; o.w = sp[3]; *(u32x4*)(I.WT + (size_t)nr * I.ldt + 8 * q) = o; }
    LDS_WAIT(); asm volatile("" ::: "memory");
}

struct Args { const float* in[21]; float* out; unsigned char* ws; int ph_lo, ph_hi; };

__device__ __forceinline__ void prologue(const Args& a, LAS unsigned char* lds, int gw, int NGW, int lane, int gtid, int NT) {
    unsigned char* ws = a.ws;
    LAS unsigned* scr = (LAS unsigned*)(lds + (gw & 7) * 16384);
    constexpr int I_IN = 32 * 192, I_WB = 8 * 32, I_WO = 32 * 32, I_UP = 32 * 128, I_DN = 128 * 32;
    constexpr int N0 = 2 * I_IN, N1 = N0 + 8 * I_WB, N2 = N1 + 2 * I_WO, N3 = N2 + 2 * I_UP, N4 = N3 + 2 * I_DN, N5 = N4 + 32, N6 = N5 + 32;
    auto make_item = [&](int it) -> TrItem {
        if (it < N0) { const int l = it / I_IN, r = it % I_IN, kb = r / 192, nb = r % 192, n0 = nb * 64, sc = n0 + (n0 >= 4096 ? 8 : 0);
            const int gperm = n0 >= 4096 ? (n0 - 4096) >> 11 : -1, nd = n0 >= 4096 ? 4096 + 256 * (((n0 - 4096) & 2047) >> 6) : n0;
            return TrItem{a.in[2] + ((size_t)l * DM + kb * 64) * NIN_SRC + sc, a.in[1] + l * DM + kb * 64, (bf16_t*)(ws + WS_WIN) + ((size_t)l * NIN + nd) * DM + kb * 64, NIN_SRC, DM, gperm}; }
        if (it < N1) { const int r0 = it - N0, lk = r0 / I_WB, r = r0 % I_WB, l = lk >> 2, kbr = lk & 3, kb = r / 32, nb = r % 32;
            return TrItem{a.in[16] + ((size_t)lk * 512 + kb * 64) * DM + nb * 64, nullptr, (bf16_t*)(ws + WS_WB) + ((size_t)l * DM + nb * 64) * DM + kbr * 512 + kb * 64, DM, DM, -1}; }
        if (it < N2) { const int r0 = it - N1, l = r0 / I_WO, r = r0 % I_WO, kb = r / 32, nb = r % 32;
            return TrItem{a.in[17] + ((size_t)l * DM + kb * 64) * DM + nb * 64, nullptr, (bf16_t*)(ws + WS_WO) + ((size_t)l * DM + nb * 64) * DM + kb * 64, DM, DM, -1}; }
        if (it < N3) { const int r0 = it - N2, l = r0 / I_UP, r = r0 % I_UP, kb = r / 128, nb = r % 128;
            return TrItem{a.in[19] + ((size_t)l * DM + kb * 64) * DFF + nb * 64, a.in[18] + l * DM + kb * 64, (bf16_t*)(ws + WS_WUP) + ((size_t)l * DFF + nb * 64) * DM + kb * 64, DFF, DM, -1}; }
        if (it < N4) { const int r0 = it - N3, l = r0 / I_DN, r = r0 % I_DN, kb = r / 32, nb = r % 32;
            return TrItem{a.in[20] + ((size_t)l * DFF + kb * 64) * DM + nb * 64, nullptr, (bf16_t*)(ws + WS_WDN) + ((size_t)l * DM + nb * 64) * DFF + kb * 64, DM, DFF, -1}; }
        if (it < N5) { const int r0 = it - N4, lg = r0 >> 2, r = r0 & 3, l = lg >> 2, g = lg & 3, kb = r >> 1, nb = r & 1;
            return TrItem{a.in[10] + ((size_t)lg * 128 + kb * 64) * 128 + nb * 64, nullptr, (bf16_t*)(ws + WS_WPOOL) + ((size_t)l * 512 + g * 128 + nb * 64) * 512 + g * 128 + kb * 64, 128, 512, -1}; }
        const int r0 = it - N5, h = r0 & 7, mat = (r0 >> 3) & 1, l = r0 >> 4;
        return TrItem{a.in[mat ? 7 : 5] + ((size_t)(l * 8 + h) * 64) * 64, nullptr, (bf16_t*)(ws + WS_WLRU) + ((size_t)l * 1024 + (h >> 1) * 256 + mat * 128 + (h & 1) * 64) * 512 + h * 64, 64, 512, -1};
    };
    for (int it = gw; it < N6; it += 2 * NGW) {
        const bool two = it + NGW < N6;
        const TrItem I0 = make_item(it), I1 = make_item(two ? it + NGW : it);
        f32x4 v0[8][2], v1[8][2];
        tr_load(I0, v0, lane); tr_load(I1, v1, lane);
        tr_finish(I0, v0, scr, lane);
        if (two) tr_finish(I1, v1, scr, lane);
    }
    for (int i = gtid; i < 2 * 512 * 16; i += NT) { const int l = i / 8192, r = (i % 8192) / 16, ch = i % 16, og = (r >> 7) ^ 1;
        *(u32x4*)((bf16_t*)(ws + WS_WPOOL) + ((size_t)l * 512 + r) * 512 + og * 128 + ch * 8) = (u32x4){0u, 0u, 0u, 0u}; }
    for (int i = gtid; i < 2 * 1024 * 8; i += NT) { const int l = i / 8192, r = (i % 8192) / 8, ch = i % 8, h = 2 * (r >> 8) + ((r & 127) >> 6), oh = h ^ 1;
        *(u32x4*)((bf16_t*)(ws + WS_WLRU) + ((size_t)l * 1024 + r) * 512 + oh * 64 + ch * 8) = (u32x4){0u, 0u, 0u, 0u}; }
    for (int i = gtid; i < 2 * 8 * DM; i += NT) { const int l = i / (8 * DM), h = (i / DM) & 7, k = i % DM;
        ((float*)(ws + WS_WF))[i] = a.in[1][l * DM + k] * a.in[2][((size_t)l * DM + k) * NIN_SRC + 4096 + h]; }
    for (int i = gtid; i < 4 * T; i += NT) ((float*)(ws + WS_SS))[T + i] = 0.f;
    for (int m0 = gw; m0 < T; m0 += 4 * NGW) { f32x4 v[4][8];
#pragma unroll
        for (int q = 0; q < 4; ++q) { const int m = (m0 + q * NGW < T) ? m0 + q * NGW : m0; const f32x4* xr = (const f32x4*)(a.in[0] + (size_t)m * DM) + lane;
#pragma unroll
            for (int j = 0; j < 8; ++j) v[q][j] = __builtin_nontemporal_load(xr + 64 * j); }
#pragma unroll
        for (int q = 0; q < 4; ++q) { const int m = m0 + q * NGW; if (m < T) { float s = 0.f; u32x2* o8 = (u32x2*)((bf16_t*)(ws + WS_XB) + (size_t)m * DM) + lane;
#pragma unroll
            for (int j = 0; j < 8; ++j) { const f32x4 x = v[q][j]; s += (x.x * x.x + x.y * x.y) + (x.z * x.z + x.w * x.w); u32x2 w; w.x = cvt_pk_bf16(x.x, x.y); w.y = cvt_pk_bf16(x.z, x.w); o8[64 * j] = w; }
            s = wave_sum(s); if (lane == 0) ((float*)(ws + WS_SS))[m] = s; } } }
}

__device__ __forceinline__ void flogit_phase(const bf16_t* xb, const float* wf, const float* ss, const float* fb, float* logf, int gw, int NGW, int lane) {
    for (int tq = gw; tq < T / 4; tq += NGW) {
        float acc[4][8];
#pragma unroll
        for (int j = 0; j < 4; ++j)
#pragma unroll
            for (int h = 0; h < 8; ++h) acc[j][h] = 0.f;
#pragma unroll
        for (int ci = 0; ci < 4; ++ci) { const int col = ci * 512 + lane * 8; float xv[4][8];
#pragma unroll
            for (int j = 0; j < 4; ++j) unpack8(*(const u32x4*)(xb + (size_t)(4 * tq + j) * DM + col), xv[j]);
#pragma unroll
            for (int h = 0; h < 8; ++h) { const f32x4 w0 = *(const f32x4*)(wf + h * DM + col), w1 = *(const f32x4*)(wf + h * DM + col + 4);
#pragma unroll
                for (int j = 0; j < 4; ++j) acc[j][h] += (xv[j][0] * w0[0] + xv[j][1] * w0[1]) + (xv[j][2] * w0[2] + xv[j][3] * w0[3]) + (xv[j][4] * w1[0] + xv[j][5] * w1[1]) + (xv[j][6] * w1[2] + xv[j][7] * w1[3]); } }
        float mine = 0.f;
#pragma unroll
        for (int j = 0; j < 4; ++j)
#pragma unroll
            for (int h = 0; h < 8; ++h) { const float v = wave_sum(acc[j][h]); if (lane == j * 8 + h) mine = v; }
        if (lane < 32) { const int t = 4 * tq + (lane >> 3), hh = lane & 7; const float z = mine * __builtin_amdgcn_rsqf(ss[t] * (1.f / DM) + EPS) + fb[hh];
            logf[t * 8 + hh] = fminf(z, 0.f) - log1pf(__expf(-fabsf(z))); }
    }
}

template <int WIN> __device__ __forceinline__ void pool_load(const bf16_t* proj, u32x4 (&w)[WIN], int t, int c, int s) {
    const int cnt = (s + 1 < WIN) ? s + 1 : WIN;
#pragma unroll
    for (int k = 0; k < WIN; ++k) w[k] = *(const u32x4*)(proj + (size_t)(k < cnt ? t - k : t) * 4096 + 512 + c);
}
template <int WIN> __device__ __forceinline__ void pool_finish(const u32x4 (&w)[WIN], bf16_t* pooled, int t, int c, int s) {
    const int cnt = (s + 1 < WIN) ? s + 1 : WIN;
    float acc[8], x0[8]; unpack8(w[0], x0);
#pragma unroll
    for (int j = 0; j < 8; ++j) acc[j] = x0[j];
#pragma unroll
    for (int k = 1; k < WIN; ++k) { float xv[8]; unpack8(w[k], xv); const float wt = k < cnt ? 1.f : 0.f;
#pragma unroll
        for (int j = 0; j < 8; ++j) acc[j] += wt * xv[j]; }
    const float inv = 1.f / (float)cnt;
#pragma unroll
    for (int j = 0; j < 8; ++j) acc[j] = acc[j] * inv - x0[j];
    *(u32x4*)(pooled + (size_t)t * 512 + c) = pack8(acc);
}
__device__ __forceinline__ void mixer_elementwise(const bf16_t* proj, const float* cw, const float* cb, const float* sw, bf16_t* ub, bf16_t* pooled, bf16_t* ycat, int gtid, int NT) {
    {
        const int c = (gtid & 63) * 8;
        float cwv[4][8], cbv[8], swv[3][8];
#pragma unroll
        for (int j = 0; j < 8; ++j) { cbv[j] = cb[c + j];
#pragma unroll
            for (int k = 0; k < 4; ++k) cwv[k][j] = cw[k * 512 + c + j];
#pragma unroll
            for (int k = 0; k < 3; ++k) swv[k][j] = sw[k * 512 + c + j]; }
        for (int i0 = gtid; i0 < T * 64; i0 += 2 * NT) {
            u32x4 xa[2][4], gc[2][3], xc[2][3], gbw[2];
#pragma unroll
            for (int h = 0; h < 2; ++h) { const int i = (i0 + h * NT < T * 64) ? i0 + h * NT : i0, t = i >> 6, sq = t & (SEQ - 1);
#pragma unroll
                for (int k = 0; k < 4; ++k) xa[h][k] = *(const u32x4*)(proj + (size_t)(sq - 3 + k >= 0 ? t - 3 + k : t) * 4096 + c);
#pragma unroll
                for (int k = 0; k < 3; ++k) { const bf16_t* p = proj + (size_t)(sq - 2 + k >= 0 ? t - 2 + k : t) * 4096; gc[h][k] = *(const u32x4*)(p + 1536 + c); xc[h][k] = *(const u32x4*)(p + 2048 + c); }
                gbw[h] = *(const u32x4*)(proj + (size_t)t * 4096 + 1024 + c); }
#pragma unroll
            for (int h = 0; h < 2; ++h) { const int i = (i0 + h * NT < T * 64) ? i0 + h * NT : i0, t = i >> 6, sq = t & (SEQ - 1);
                float acc[8], ac2[8];
#pragma unroll
                for (int j = 0; j < 8; ++j) { acc[j] = cbv[j]; ac2[j] = 0.f; }
#pragma unroll
                for (int k = 0; k < 4; ++k) { float xv[8]; unpack8(xa[h][k], xv); const float wt = (sq - 3 + k >= 0) ? 1.f : 0.f;
#pragma unroll
                    for (int j = 0; j < 8; ++j) acc[j] += wt * cwv[k][j] * xv[j]; }
                *(u32x4*)(ub + (size_t)t * 512 + c) = pack8(acc);
#pragma unroll
                for (int k = 0; k < 3; ++k) { float g8[8], x8[8]; unpack8(gc[h][k], g8); unpack8(xc[h][k], x8); const float wt = (sq - 2 + k >= 0) ? 1.f : 0.f;
#pragma unroll
                    for (int j = 0; j < 8; ++j) ac2[j] += wt * swv[k][j] * (g8[j] * x8[j]); }
                float gb8[8]; unpack8(gbw[h], gb8);
#pragma unroll
                for (int j = 0; j < 8; ++j) ac2[j] *= gb8[j];
                *(u32x4*)(ycat + (size_t)t * DM + 1024 + c) = pack8(ac2); }
        }
    }
    for (int i = gtid; i < T * 16; i += NT) { const int t = i >> 4, cc = (i & 15) * 8, sq = t & (SEQ - 1);
        u32x4 w2[2], w4[4], w8[8], w16[16];
        pool_load<2>(proj, w2, t, cc, sq); pool_load<4>(proj, w4, t, 128 + cc, sq); pool_load<8>(proj, w8, t, 256 + cc, sq); pool_load<16>(proj, w16, t, 384 + cc, sq);
        pool_finish<2>(w2, pooled, t, cc, sq); pool_finish<4>(w4, pooled, t, 128 + cc, sq); pool_finish<8>(w8, pooled, t, 256 + cc, sq); pool_finish<16>(w16, pooled, t, 384 + cc, sq); }
}

typedef short v4i16_t __attribute__((ext_vector_type(4)));
constexpr int AT_K = 0, AT_V = 9216, AT_BIAS = 18432, AT_WS = 26624, AT_PITCH = 144;
__device__ __forceinline__ void attn_unit(LAS unsigned char* lds, int b, int h, int qblk, const bf16_t* proj, const float* logf, const float* qg, const float* kg, bf16_t* ycat) {
    int tid_ = threadIdx.x; asm volatile("" : "+v"(tid_));
    const int tid = tid_, wid = __builtin_amdgcn_readfirstlane(tid >> 6), lane = tid & 63, li = lane & 15, g = lane >> 4;
    LAS float* bias = (LAS float*)(lds + AT_BIAS); LAS float* wsum = (LAS float*)(lds + AT_WS);
    const int qrow = b * SEQ + qblk * 128 + wid * 16 + li;
    const int srow = tid >> 3, sch = tid & 7;
    const bf16_t* kvp = proj + (size_t)(b * SEQ + srow) * 4096 + h * 64 + sch * 8;
    const bf16_t* qp = proj + (size_t)qrow * 4096 + 2560 + h * 64 + 8 * g;
    float lf[4];
#pragma unroll
    for (int j = 0; j < 4; ++j) lf[j] = logf[(size_t)(b * SEQ + 4 * tid + j) * 8 + h];
    const u32x4 qw0 = *(const u32x4*)qp, qw1 = *(const u32x4*)(qp + 32);
    const f32x4 qga = *(const f32x4*)(qg + 8 * g), qgb = *(const f32x4*)(qg + 8 * g + 4), qgc = *(const f32x4*)(qg + 32 + 8 * g), qgd = *(const f32x4*)(qg + 32 + 8 * g + 4);
    const f32x4 kga = *(const f32x4*)(kg + sch * 8), kgb = *(const f32x4*)(kg + sch * 8 + 4);
    u32x4 kreg = *(const u32x4*)(kvp + 3072), vreg = *(const u32x4*)(kvp + 3584);
    __syncthreads();
    {
        float v[4]; float run = 0.f;
#pragma unroll
        for (int j = 0; j < 4; ++j) { run += lf[j]; v[j] = run; }
        float incl = run;
#pragma unroll
        for (int o = 1; o < 64; o <<= 1) { const float n = __shfl_up(incl, o); if (lane >= o) incl += n; }
        if (lane == 63) wsum[wid] = incl;
        __syncthreads();
        float off = incl - run;
        for (int w = 0; w < wid; ++w) off += wsum[w];
#pragma unroll
        for (int j = 0; j < 4; ++j) bias[4 * tid + j] = -(off + v[j]) * LOG2E;
    }
    bf16x8 qf[2];
    {
        float q0[8], q1[8]; unpack8(qw0, q0); unpack8(qw1, q1);
        const float qg0[8] = {qga[0], qga[1], qga[2], qga[3], qgb[0], qgb[1], qgb[2], qgb[3]}, qg1[8] = {qgc[0], qgc[1], qgc[2], qgc[3], qgd[0], qgd[1], qgd[2], qgd[3]};
        float s = 0.f;
#pragma unroll
        for (int j = 0; j < 8; ++j) s += q0[j] * q0[j] + q1[j] * q1[j];
        s += __shfl_xor(s, 16); s += __shfl_xor(s, 32);
        const float rq = __builtin_amdgcn_rsqf(s * (1.f / 64.f) + EPS) * (0.125f * LOG2E);
#pragma unroll
        for (int j = 0; j < 8; ++j) { q0[j] *= rq * qg0[j]; q1[j] *= rq * qg1[j]; }
        const u32x4 w0 = pack8(q0), w1 = pack8(q1); qf[0] = __builtin_bit_cast(bf16x8, w0); qf[1] = __builtin_bit_cast(bf16x8, w1);
    }
    const float kgv[8] = {kga[0], kga[1], kga[2], kga[3], kgb[0], kgb[1], kgb[2], kgb[3]};
    const int ntiles = 2 * (qblk + 1);
    const int qbase = qblk * 128 + wid * 16;
    f32x4 oacc[4];
#pragma unroll
    for (int d = 0; d < 4; ++d) oacc[d] = (f32x4){0.f, 0.f, 0.f, 0.f};
    float mrun = -INFINITY, lsum = 0.f;
    for (int kt = 0; kt < ntiles; ++kt) {
        __syncthreads();
        {
            float kv[8]; unpack8(kreg, kv); float s = 0.f;
#pragma unroll
            for (int j = 0; j < 8; ++j) s += kv[j] * kv[j];
            s += __shfl_xor(s, 1); s += __shfl_xor(s, 2); s += __shfl_xor(s, 4);
            const float rk = __builtin_amdgcn_rsqf(s * (1.f / 64.f) + EPS);
#pragma unroll
            for (int j = 0; j < 8; ++j) kv[j] *= rk * kgv[j];
            *(LAS u32x4*)(lds + AT_K + srow * AT_PITCH + sch * 16) = pack8(kv);
            *(LAS u32x4*)(lds + AT_V + srow * AT_PITCH + sch * 16) = vreg;
        }
        __syncthreads();
        if (kt + 1 < ntiles) { const bf16_t* p = kvp + (size_t)(kt + 1) * 64 * 4096; kreg = *(const u32x4*)(p + 3072); vreg = *(const u32x4*)(p + 3584); }
        if (kt * 64 <= qbase) {
            f32x4 sacc[4];
#pragma unroll
            for (int t4 = 0; t4 < 4; ++t4) sacc[t4] = *(const LAS f32x4*)(bias + kt * 64 + 16 * t4 + 4 * g);
#pragma unroll
            for (int ks = 0; ks < 2; ++ks)
#pragma unroll
                for (int t4 = 0; t4 < 4; ++t4) { const bf16x8 kf = *(const LAS bf16x8*)(lds + AT_K + (16 * t4 + li) * AT_PITCH + ks * 64 + g * 16);
                    sacc[t4] = __builtin_amdgcn_mfma_f32_16x16x32_bf16(kf, qf[ks], sacc[t4], 0, 0, 0); }
            if (kt * 64 + 63 > qbase) {
#pragma unroll
                for (int t4 = 0; t4 < 4; ++t4)
#pragma unroll
                    for (int r = 0; r < 4; ++r) if (kt * 64 + 16 * t4 + 4 * g + r > qbase + li) sacc[t4][r] = -INFINITY;
            }
            float mx = sacc[0][0];
#pragma unroll
            for (int t4 = 0; t4 < 4; ++t4)
#pragma unroll
                for (int r = 0; r < 4; ++r) mx = fmaxf(mx, sacc[t4][r]);
            mx = fmaxf(mx, __shfl_xor(mx, 16)); mx = fmaxf(mx, __shfl_xor(mx, 32));
            const float mnew = fmaxf(mrun, mx), alpha = __builtin_amdgcn_exp2f(mrun - mnew);
            mrun = mnew; float ps = 0.f;
#pragma unroll
            for (int t4 = 0; t4 < 4; ++t4)
#pragma unroll
                for (int r = 0; r < 4; ++r) { const float p = __builtin_amdgcn_exp2f(sacc[t4][r] - mnew); sacc[t4][r] = p; ps += p; }
            lsum = lsum * alpha + ps;
#pragma unroll
            for (int d = 0; d < 4; ++d) oacc[d] *= alpha;
            bf16x8 pf[2];
#pragma unroll
            for (int kb = 0; kb < 2; ++kb) { u32x4 w; w.x = cvt_pk_bf16(sacc[2 * kb][0], sacc[2 * kb][1]); w.y = cvt_pk_bf16(sacc[2 * kb][2], sacc[2 * kb][3]);
                w.z = cvt_pk_bf16(sacc[2 * kb + 1][0], sacc[2 * kb + 1][1]); w.w = cvt_pk_bf16(sacc[2 * kb + 1][2], sacc[2 * kb + 1][3]); pf[kb] = __builtin_bit_cast(bf16x8, w); }
#pragma unroll
            for (int kb = 0; kb < 2; ++kb)
#pragma unroll
                for (int d = 0; d < 4; ++d) {
                    LAS unsigned char* vp = lds + AT_V + (32 * kb + 4 * g + (li >> 2)) * AT_PITCH + (16 * d + 4 * (li & 3)) * 2;
                    const v4i16_t t0 = __builtin_amdgcn_ds_read_tr16_b64_v4i16((LAS v4i16_t*)vp);
                    const v4i16_t t1 = __builtin_amdgcn_ds_read_tr16_b64_v4i16((LAS v4i16_t*)(vp + 16 * AT_PITCH));
                    bf16x8 vf; vf[0] = t0[0]; vf[1] = t0[1]; vf[2] = t0[2]; vf[3] = t0[3]; vf[4] = t1[0]; vf[5] = t1[1]; vf[6] = t1[2]; vf[7] = t1[3];
                    oacc[d] = __builtin_amdgcn_mfma_f32_16x16x32_bf16(vf, pf[kb], oacc[d], 0, 0, 0); }
        }
    }
    lsum += __shfl_xor(lsum, 16); lsum += __shfl_xor(lsum, 32);
    const float inv = 1.f / lsum;
    bf16_t* op = ycat + (size_t)qrow * DM + 1536 + h * 64 + 4 * g;
#pragma unroll
    for (int d = 0; d < 4; ++d) { u32x2 w; w.x = cvt_pk_bf16(oacc[d][0] * inv, oacc[d][1] * inv); w.y = cvt_pk_bf16(oacc[d][2] * inv, oacc[d][3] * inv); *(u32x2*)(op + 16 * d) = w; }
}

__device__ __forceinline__ void lru_ai(float r, float gu, float sp8, float& a, float& x) {
    const float la = r * sp8, x2 = 2.f * la; a = __expf(la);
    const float om = (x2 > -0.05f) ? -x2 * (1.f + x2 * (0.5f + x2 * (1.f / 6.f + x2 * (1.f / 24.f + x2 * (1.f / 120.f))))) : 1.f - __expf(x2);
    x = sqrtf(fmaxf(om, 0.f)) * gu;
}
__device__ __forceinline__ void scan_unit(LAS unsigned char* lds, int unit, const float* rb, const float* gb, const float* lam, bf16_t* ycat) {
    int tid_ = threadIdx.x; asm volatile("" : "+v"(tid_));
    const int tid = tid_, seg = tid >> 3, cl = tid & 7, b = unit >> 6, ch = (unit & 63) * 8 + cl;
    LAS float* LA = (LAS float*)lds + tid; LAS float* LX = LA + 32 * 512;
    LAS float* sA = (LAS float*)(lds + 131072); LAS float* sH = sA + 512;
    const size_t base = ((size_t)b * SEQ + seg * 32) * 512 + ch;
    __syncthreads();
#pragma unroll
    for (int i = 0; i < 32; ++i) { LA[i * 512] = rb[base + (size_t)i * 512]; LX[i * 512] = gb[base + (size_t)i * 512]; }
    const float sp8 = -8.f * log1pf(__expf(-lam[ch]));
    float A = 1.f, H = 0.f;
#pragma unroll 2
    for (int i = 0; i < 32; ++i) { float a, x; lru_ai(LA[i * 512], LX[i * 512], sp8, a, x); LA[i * 512] = a; LX[i * 512] = x; H = a * H + x; A *= a; }
    sA[seg * 8 + cl] = A; sH[seg * 8 + cl] = H;
    __syncthreads();
    float hc = 0.f;
    for (int s2 = 0; s2 < seg; ++s2) hc = sA[s2 * 8 + cl] * hc + sH[s2 * 8 + cl];
    bf16_t* yp = ycat + ((size_t)b * SEQ + seg * 32) * DM + ch;
#pragma unroll 4
    for (int i = 0; i < 32; ++i) { hc = LA[i * 512] * hc + LX[i * 512]; yp[(size_t)i * DM] = (bf16_t)(cvt_pk_bf16(hc, 0.f) & 0xffffu); }
}

#define XB_TMO      128
#define XB_XCNT(j)  (256  + 64 * (j))
#define XB_XSUB(j)  (1280 + 64 * (j))
#define XB_XGEN(j)  (2304 + 64 * (j))
#define XB_TOP      3328
#define XB_TOPGEN   3392
#define XCD_BAR_WORDS 3456
#define XB_SPIN_CAP (1u << 18)
__device__ __forceinline__ unsigned xb_ld(unsigned* p)              { return __hip_atomic_load(p, __ATOMIC_RELAXED, __HIP_MEMORY_SCOPE_AGENT); }
__device__ __forceinline__ unsigned xb_add(unsigned* p, unsigned v) { return __hip_atomic_fetch_add(p, v, __ATOMIC_RELAXED, __HIP_MEMORY_SCOPE_AGENT); }
__device__ __forceinline__ unsigned xb_xcc_id() { return (unsigned)__builtin_amdgcn_s_getreg((3 << 11) | 20) & 0xFu; }
#define XB_SPIN(cond, bar) do { unsigned _sp = 0; while (cond) { __builtin_amdgcn_s_sleep(1); \
    if ((++_sp & 255u) == 0u) { if (xb_ld(&(bar)[XB_TMO])) break; if (_sp > XB_SPIN_CAP) { atomicAdd(&(bar)[XB_TMO], 1u); break; } } } } while (0)
struct XcdBarrier { unsigned* bar; unsigned x; volatile LAS unsigned* st; };
__device__ __forceinline__ void xcd_barrier_complete(unsigned* bar, unsigned x, unsigned& nloc, unsigned& nx) {
    const unsigned G = gridDim.x * gridDim.y * gridDim.z;
    unsigned sum, cnt, mine, sp = 0u;
    for (;;) {
        sum = 0u; cnt = 0u; mine = 0u;
#pragma unroll
        for (unsigned j = 0; j < 16; ++j) { const unsigned c = xb_ld(&bar[XB_XCNT(j)]); sum += c; cnt += (c > 0u) ? 1u : 0u; mine = (j == x) ? c : mine; }
        if (sum == G) break;
        __builtin_amdgcn_s_sleep(1);
        if ((++sp & 255u) == 0u) { if (xb_ld(&bar[XB_TMO])) break; if (sp > XB_SPIN_CAP) { atomicAdd(&bar[XB_TMO], 1u); break; } }
    }
    nloc = mine > 0u ? mine : 1u; nx = cnt > 0u ? cnt : 1u;
}
__device__ __forceinline__ void xcd_barrier(const XcdBarrier& b) {
    asm volatile("s_waitcnt vmcnt(0)" ::: "memory");
    __syncthreads();
    if (threadIdx.x == 0) {
        unsigned* bar = b.bar;
        __builtin_amdgcn_s_waitcnt(0);
        unsigned nloc = b.st[0], nx = b.st[1];
        if (nloc == 0u) { xcd_barrier_complete(bar, b.x, nloc, nx); b.st[0] = nloc; b.st[1] = nx; }
        const unsigned old = xb_add(&bar[XB_XSUB(b.x)], 1u);
        const unsigned gen = old / nloc;
        if (old + 1u == (gen + 1u) * nloc) {
            __builtin_amdgcn_fence(__ATOMIC_RELEASE, "agent");
            asm volatile("s_waitcnt vmcnt(0)" ::: "memory");
            const unsigned og = xb_add(&bar[XB_TOP], 1u);
            const unsigned tg = og / nx;
            if (og + 1u == (tg + 1u) * nx) xb_add(&bar[XB_TOPGEN], 1u);
            else XB_SPIN(xb_ld(&bar[XB_TOPGEN]) == tg, bar);
            __builtin_amdgcn_fence(__ATOMIC_ACQUIRE, "agent");
            xb_add(&bar[XB_XGEN(b.x)], 1u);
            asm volatile("s_waitcnt vmcnt(0)" ::: "memory");
        } else {
            XB_SPIN(xb_ld(&bar[XB_XGEN(b.x)]) == gen, bar);
            __builtin_amdgcn_fence(__ATOMIC_ACQUIRE, "agent");
            asm volatile("s_waitcnt vmcnt(0)" ::: "memory");
        }
    }
    __syncthreads();
}
constexpr size_t WS_BAR = 512 * 1024;
constexpr int LDS_BARST = LDS_BYTES - 64;

constexpr int NPHASE = 17;
__global__ void __launch_bounds__(512, 2) fwd_megakernel(Args args) {
    extern __shared__ __attribute__((aligned(16))) unsigned char lds_raw[];
    LAS unsigned char* lds = (LAS unsigned char*)lds_raw;
    cg::grid_group grid = cg::this_grid();
    const int G = gridDim.x, c = blockIdx.x, NGW = G * 8, NT = G * 512;
    const int lo = args.ph_lo, hi = args.ph_hi;
    if (threadIdx.x == 0) { ((volatile LAS unsigned*)(lds + LDS_BARST))[0] = 0u; ((volatile LAS unsigned*)(lds + LDS_BARST))[1] = 0u; (void)xb_add((unsigned*)(args.ws + WS_BAR) + XB_XCNT(xb_xcc_id()), 1u); }
    __syncthreads();
#define PHASE_PTRS(l) \
    const Args* ap = (const Args*)__builtin_amdgcn_kernarg_segment_ptr(); int lq = (l); asm volatile("" : "+s"(ap), "+s"(lq)); \
    int tidq = threadIdx.x; asm volatile("" : "+v"(tidq)); const int lane = tidq & 63, gw = c * 8 + (tidq >> 6), gtid = c * 512 + tidq; (void)lane; (void)gw; (void)gtid; \
    unsigned char* ws = ap->ws; \
    float* ss = (float*)(ws + WS_SS); float* logf = (float*)(ws + WS_LOGF); \
    bf16_t* xb = (bf16_t*)(ws + WS_XB); float* xres = (float*)(ws + WS_XRES); bf16_t* proj = (bf16_t*)(ws + WS_PROJ); bf16_t* gates = (bf16_t*)(ws + WS_GATES); bf16_t* hbuf = (bf16_t*)(ws + WS_HBUF); \
    bf16_t* ycat = (bf16_t*)(ws + WS_YCAT); float* mf32 = (float*)(ws + WS_MF32); bf16_t* mb = (bf16_t*)(ws + WS_MB); bf16_t* ub = (bf16_t*)(ws + WS_U); bf16_t* pooled = (bf16_t*)(ws + WS_POOLED); \
    float* abuf = (float*)(ws + WS_A); float* ibuf = (float*)(ws + WS_INP); \
    (void)ss; (void)logf; (void)xb; (void)xres; (void)proj; (void)gates; (void)hbuf; (void)ycat; (void)mf32; (void)mb; (void)ub; (void)pooled; (void)abuf; (void)ibuf;
#define IN(k) (lo <= (k) && (k) < hi)
#define SEAM(k) do { if (IN(k) && IN((k) + 1)) { XcdBarrier xb_; { const Args* ap_ = (const Args*)__builtin_amdgcn_kernarg_segment_ptr(); asm volatile("" : "+s"(ap_)); xb_.bar = (unsigned*)(ap_->ws + WS_BAR); } \
        xb_.x = xb_xcc_id(); xb_.st = (volatile LAS unsigned*)(lds + LDS_BARST); xcd_barrier(xb_); } } while (0)

    if (IN(0)) { PHASE_PTRS(0) prologue(*ap, lds, gw, NGW, lane, gtid, NT); __syncthreads(); }
    if (lo < 0) grid.sync();
    SEAM(0);
    for (int l = 0; l < NLAYER; ++l) {
        const int p0 = 1 + 8 * l;
        if (IN(p0)) { PHASE_PTRS(l)
            flogit_phase(xb, (const float*)(ws + WS_WF) + lq * 8 * DM, ss + (2 * lq) * T, ap->in[15] + lq * 8, logf, gw, NGW, lane);
            __syncthreads();
            pg8::Gemm g{xb, (const bf16_t*)(ws + WS_WIN) + (size_t)lq * NIN * DM, DM, DM, DM}; pg8::SchedStd S; S.so.init(T, NIN, G, c);
            pg8::EpiInProj E{ss + (2 * lq) * T, proj, gates};
            pg8::gemm_phase(lds, g, S, E);
        }
        SEAM(p0);
        if (IN(p0 + 1)) { PHASE_PTRS(l)
            mixer_elementwise(proj, ap->in[3] + lq * 4 * 512, ap->in[4] + lq * 512, ap->in[12] + lq * 3 * 512, ub, pooled, ycat, gtid, NT);
            for (int i = 0;; ++i) { const int idx = c + G * i; if (idx >= 512) break; const int bh = idx & 31, z = idx >> 5, qblk = (z < 8) ? 15 - z : z - 8;
                attn_unit(lds, bh >> 3, bh & 7, qblk, proj, logf, ap->in[13] + lq * 64, ap->in[14] + lq * 64, ycat); }
            __syncthreads();
        }
        SEAM(p0 + 1);
        if (IN(p0 + 2)) { PHASE_PTRS(l)
            { pg8::Gemm g{pooled, (const bf16_t*)(ws + WS_WPOOL) + (size_t)lq * 512 * 512, 512, 512, 256}; pg8::SchedSmall S{32, 2, G, c, 0, 512u}; pg8::EpiPool E{ap->in[11] + lq * 512, ycat}; pg8::gemm_phase(lds, g, S, E); }
            { pg8::Gemm g{ub, (const bf16_t*)(ws + WS_WLRU) + (size_t)lq * 1024 * 512, 512, 512, 128}; pg8::SchedSmall S{32, 4, G, c, 64 % G, 256u};
              pg8::EpiLru E{ap->in[6] + lq * 512, ap->in[8] + lq * 512, ub, abuf, ibuf}; pg8::gemm_phase(lds, g, S, E); }
        }
        SEAM(p0 + 2);
        if (IN(p0 + 3)) { PHASE_PTRS(l) for (int u = c; u < 256; u += G) scan_unit(lds, u, abuf, ibuf, ap->in[9] + lq * 512, ycat); __syncthreads(); }
        SEAM(p0 + 3);
        if (IN(p0 + 4)) { PHASE_PTRS(l) pg8::Gemm g{ycat, (const bf16_t*)(ws + WS_WB) + (size_t)lq * DM * DM, DM, DM, 512}; pg8::SchedSeg S; S.so.init(T, DM, G, c); S.nseg = 4; S.segbytes = 1024u;
            pg8::EpiBranch E{gates, mb}; pg8::gemm_phase(lds, g, S, E); }
        SEAM(p0 + 4);
        if (IN(p0 + 5)) { PHASE_PTRS(l) pg8::Gemm g{mb, (const bf16_t*)(ws + WS_WO) + (size_t)lq * DM * DM, DM, DM, DM}; pg8::SchedStd S; S.so.init(T, DM, G, c);
            pg8::EpiResid E{xb, ss + (2 * lq + 1) * T, nullptr, nullptr}; pg8::gemm_phase(lds, g, S, E); }
        SEAM(p0 + 5);
        if (IN(p0 + 6)) { PHASE_PTRS(l) pg8::Gemm g{xb, (const bf16_t*)(ws + WS_WUP) + (size_t)lq * DFF * DM, DM, DM, DM}; pg8::SchedStd S; S.so.init(T, DFF, G, c);
            pg8::EpiUp E{hbuf}; pg8::gemm_phase(lds, g, S, E); }
        SEAM(p0 + 6);
        if (IN(p0 + 7)) { PHASE_PTRS(l) pg8::Gemm g{hbuf, (const bf16_t*)(ws + WS_WDN) + (size_t)lq * DM * DFF, DFF, DFF, DFF}; pg8::SchedStd S; S.so.init(T, DM, G, c);
            pg8::EpiResid E{xb, ss + (2 * lq + 2) * T, lq == NLAYER - 1 ? ap->out : nullptr, ss + (2 * lq + 1) * T}; pg8::gemm_phase(lds, g, S, E); }
        if (l + 1 < NLAYER) SEAM(p0 + 7);
    }
#undef IN
#undef SEAM
}

#ifndef MK_N_LAUNCHES
#define MK_N_LAUNCHES 1
#endif
extern "C" void kernel_launch(void* const* d_in, const int* in_sizes, int n_in, void* d_out, int out_size, void* d_ws, size_t ws_size, hipStream_t stream) {
    static int grid = 0;
    if (grid == 0) {
        if (n_in != 21 || ws_size < WS_END) { fprintf(stderr, "kernel_launch: unexpected n_in %d / ws_size %zu\n", n_in, ws_size); grid = -1; return; }
        int dev = 0, cus = 0, per_cu = 0;
        hipGetDevice(&dev); hipDeviceGetAttribute(&cus, hipDeviceAttributeMultiprocessorCount, dev);
        if (hipFuncSetAttribute((const void*)fwd_megakernel, hipFuncAttributeMaxDynamicSharedMemorySize, LDS_BYTES) != hipSuccess) { fprintf(stderr, "kernel_launch: hipFuncSetAttribute failed\n"); grid = -1; return; }
        if (hipOccupancyMaxActiveBlocksPerMultiprocessor(&per_cu, (const void*)fwd_megakernel, 512, LDS_BYTES) != hipSuccess || per_cu < 1) { fprintf(stderr, "kernel_launch: occupancy query says %d\n", per_cu); per_cu = 1; }
        (void)hipGetLastError();
        grid = cus * 1;
    }
    if (grid < 0) return;
    if (hipMemsetAsync((char*)d_ws + WS_BAR, 0, 16384, stream) != hipSuccess) { fprintf(stderr, "kernel_launch: memset failed\n"); return; }
    Args a{};
    for (int i = 0; i < 21; ++i) a.in[i] = (const float*)d_in[i];
    a.out = (float*)d_out; a.ws = (unsigned char*)d_ws;
#if MK_N_LAUNCHES == 1
    a.ph_lo = 0; a.ph_hi = NPHASE;
    void* kargs[] = {&a};
    hipError_t e = hipLaunchCooperativeKernel((const void*)fwd_megakernel, dim3(grid), dim3(512), kargs, LDS_BYTES, stream);
    if (e != hipSuccess) fprintf(stderr, "cooperative launch failed: %s (grid %d)\n", hipGetErrorString(e), grid);
#else
    for (int p = 0; p < NPHASE; ++p) { a.ph_lo = p; a.ph_hi = p + 1; hipLaunchKernelGGL(fwd_megakernel, dim3(grid), dim3(512), LDS_BYTES, stream, a); }
#endif
}
```

```cpp
#include <hip/hip_runtime.h>
#include <hip/hip_cooperative_groups.h>
#include <cstdio>
#include <cstdint>
namespace cg = cooperative_groups;

#define LAS __attribute__((address_space(3)))
typedef unsigned short bf16_t;
typedef short bf16x8 __attribute__((ext_vector_type(8)));
typedef short s16x4 __attribute__((ext_vector_type(4)));
typedef float f32x4 __attribute__((ext_vector_type(4)));
typedef unsigned u32x4 __attribute__((ext_vector_type(4)));
typedef unsigned u32x2 __attribute__((ext_vector_type(2)));

constexpr int T = 8192, SEQ = 2048, DM = 2048, NIN_SRC = 12296, NIN = 12288, DFF = 8192, NLAYER = 2;
constexpr float EPS = 1e-6f, LOG2E = 1.4426950408889634f;
constexpr size_t MiB = 1u << 20;
constexpr size_t WS_SS = 0, WS_LOGF = 1 * MiB, WS_WF = 2 * MiB, WS_WPOOL = 3 * MiB, WS_WLRU = 4 * MiB, WS_WIN = 8 * MiB, WS_WB = 104 * MiB, WS_WO = 120 * MiB,
                 WS_WUP = 136 * MiB, WS_WDN = 200 * MiB, WS_XB = 264 * MiB, WS_XRES = 296 * MiB, WS_PROJ = 360 * MiB, WS_GATES = 424 * MiB, WS_HBUF = 424 * MiB,
                 WS_YCAT = 552 * MiB, WS_MF32 = 584 * MiB, WS_MB = 648 * MiB, WS_U = 680 * MiB, WS_POOLED = 688 * MiB, WS_A = 696 * MiB, WS_INP = 712 * MiB, WS_END = 728 * MiB;
constexpr int LDS_BYTES = 147456;

__device__ __forceinline__ unsigned cvt_pk_bf16(float lo, float hi) { unsigned r; asm volatile("v_cvt_pk_bf16_f32 %0, %1, %2" : "=v"(r) : "v"(lo), "v"(hi)); return r; }
__device__ __forceinline__ float bf_lo(unsigned w) { return __builtin_bit_cast(float, w << 16); }
__device__ __forceinline__ float bf_hi(unsigned w) { return __builtin_bit_cast(float, w & 0xffff0000u); }
__device__ __forceinline__ void unpack8(u32x4 w, float (&f)[8]) { f[0] = bf_lo(w.x); f[1] = bf_hi(w.x); f[2] = bf_lo(w.y); f[3] = bf_hi(w.y); f[4] = bf_lo(w.z); f[5] = bf_hi(w.z); f[6] = bf_lo(w.w); f[7] = bf_hi(w.w); }
__device__ __forceinline__ u32x4 pack8(const float (&f)[8]) { u32x4 w; w.x = cvt_pk_bf16(f[0], f[1]); w.y = cvt_pk_bf16(f[2], f[3]); w.z = cvt_pk_bf16(f[4], f[5]); w.w = cvt_pk_bf16(f[6], f[7]); return w; }
__device__ __forceinline__ float fsigmoid(float v) { return __builtin_amdgcn_rcpf(1.f + __builtin_amdgcn_exp2f(-v * LOG2E)); }
__device__ __forceinline__ float wave_sum(float v) {
#pragma unroll
    for (int o = 1; o < 64; o <<= 1) v += __shfl_xor(v, o);
    return v;
}

namespace pg8 {
constexpr int BM = 256, BK = 64, HALF = 128, HTB = HALF * BK * 2, STAGE_BYTES = 8 * HTB, NXCD = 8, WGM = 4;
__host__ __device__ __forceinline__ int lds_byte(int r, int c) { const int st = (r >> 4) * 2 + (c >> 5), rr = r & 15, cc = c & 31, ob = rr * 64 + cc * 2; return st * 1024 + (ob ^ (((ob >> 9) & 1) << 5)); }
__host__ __device__ __forceinline__ void stage_rc(int b, int& R, int& C) { const int st = b / 1024, sb = b % 1024, swz = sb ^ (((sb >> 9) & 1) << 5); R = (st >> 1) * 16 + swz / 64; C = (st & 1) * 32 + (swz % 64) / 2; }
__host__ __device__ __forceinline__ int perm32(int rho) { const int n = rho >> 4, i = rho & 15; return 8 * (i >> 2) + 4 * n + (i & 3); }

struct Unit { int pm, pn, ks; unsigned koff; };
struct Gemm { const bf16_t* A; const bf16_t* Bt; int lda, ldb, K; };

struct StaticOrder {
    int nM, nN, nwg, G, c;
    __device__ void init(int M, int N, int G_, int c_) { nM = M / BM; nN = N / BM; nwg = nM * nN; G = G_; c = c_; }
    __device__ bool tile(int i, int& pm, int& pn) const {
        const long L = (long)i * G + c; if (L >= nwg) return false;
        int wgid = (int)L; { const int q = nwg / NXCD, r = nwg % NXCD, xcd = wgid % NXCD, off = wgid / NXCD; wgid = (xcd < r ? xcd * (q + 1) : r * (q + 1) + (xcd - r) * q) + off; }
        const int nig = WGM * nN, gid = wgid / nig, fm = gid * WGM, gsz = (nM - fm) < WGM ? (nM - fm) : WGM;
        pm = fm + ((wgid % nig) % gsz); pn = (wgid % nig) / gsz; return true;
    }
};
struct SchedStd { StaticOrder so; __device__ bool next(int i, Unit& u) const { u.ks = 0; u.koff = 0; return so.tile(i, u.pm, u.pn); } };
struct SchedSeg { StaticOrder so; int nseg; unsigned segbytes;
    __device__ bool next(int i, Unit& u) const { u.ks = i % nseg; u.koff = (unsigned)u.ks * segbytes; return so.tile(i / nseg, u.pm, u.pn); } };
struct SchedSmall { int nM, nN, G, c, cu_off; unsigned pnbytes;
    __device__ bool next(int i, Unit& u) const { const int idx = i * G + ((c - cu_off + G) % G); if (idx >= nM * nN) return false; u.pm = idx / nN; u.pn = idx % nN; u.ks = 0; u.koff = (unsigned)u.pn * pnbytes; return true; } };

typedef f32x4 AccT[2][2][4][2];

struct EpiInProj {
    static constexpr bool CARRY = false;
    const float* ss; bf16_t* proj; bf16_t* gates;
    __device__ __forceinline__ void operator()(AccT& acc, const Unit& u, int wr, int wc, int fr, int fq) const {
        const int row0 = u.pm * BM + wr * 64 + fr; const bool isg = u.pn >= 16;
        float rs[2][4];
#pragma unroll
        for (int ai = 0; ai < 2; ++ai)
#pragma unroll
            for (int m = 0; m < 4; ++m) rs[ai][m] = ss[row0 + ai * HALF + m * 16];
        if (!isg) { const int col0 = u.pn * BM + wc * 32 + 8 * fq;
#pragma unroll
            for (int ai = 0; ai < 2; ++ai)
#pragma unroll
                for (int m = 0; m < 4; ++m) { const int row = row0 + ai * HALF + m * 16; const float r = __builtin_amdgcn_rsqf(rs[ai][m] * (1.f / DM) + EPS);
#pragma unroll
                    for (int bj = 0; bj < 2; ++bj) { const f32x4 v0 = acc[ai][bj][m][0] * r, v1 = acc[ai][bj][m][1] * r;
                        u32x4 w; w.x = cvt_pk_bf16(v0[0], v0[1]); w.y = cvt_pk_bf16(v0[2], v0[3]); w.z = cvt_pk_bf16(v1[0], v1[1]); w.w = cvt_pk_bf16(v1[2], v1[3]);
                        *(u32x4*)(proj + (size_t)row * 4096 + col0 + bj * HALF) = w; } }
        } else { const int d0 = (u.pn - 16) * 64 + 16 * wc + 4 * fq;
#pragma unroll
            for (int ai = 0; ai < 2; ++ai)
#pragma unroll
                for (int m = 0; m < 4; ++m) { const int row = row0 + ai * HALF + m * 16; const float r = __builtin_amdgcn_rsqf(rs[ai][m] * (1.f / DM) + EPS);
                    f32x4 g[4], sden[4];
#pragma unroll
                    for (int k = 0; k < 4; ++k)
#pragma unroll
                        for (int i = 0; i < 4; ++i) { const float e = fminf(__builtin_amdgcn_exp2f(-(acc[ai][k >> 1][m][k & 1][i] * r) * LOG2E), 1e12f); sden[k][i] = 1.f + e; g[k][i] = __builtin_amdgcn_rcpf(sden[k][i]); }
                    bf16_t* gp = gates + (size_t)row * 8192 + d0;
#pragma unroll
                    for (int k = 0; k < 4; ++k) { f32x4 mk = g[k];
                        if (k < 3) {
#pragma unroll
                            for (int i = 0; i < 4; ++i) mk[i] *= sden[k + 1][i]; }
                        u32x2 w; w.x = cvt_pk_bf16(mk[0], mk[1]); w.y = cvt_pk_bf16(mk[2], mk[3]); *(u32x2*)(gp + k * 2048) = w; } }
        }
    }
};
struct EpiBranch {
    static constexpr bool CARRY = true;
    const bf16_t* gates; bf16_t* mb;
    __device__ __forceinline__ void operator()(AccT& acc, const Unit& u, int wr, int wc, int fr, int fq) const {
        const int row0 = u.pm * BM + wr * 64 + fr, col0 = u.pn * BM + wc * 32 + 8 * fq, ks = u.ks; const bool fin = ks == 3;
        u32x4 gc[2][4][2];
#pragma unroll
        for (int ai = 0; ai < 2; ++ai)
#pragma unroll
            for (int m = 0; m < 4; ++m)
#pragma unroll
                for (int bj = 0; bj < 2; ++bj) gc[ai][m][bj] = *(const u32x4*)(gates + (size_t)(row0 + ai * HALF + m * 16) * 8192 + ks * 2048 + col0 + bj * HALF);
#pragma unroll
        for (int ai = 0; ai < 2; ++ai)
#pragma unroll
            for (int m = 0; m < 4; ++m)
#pragma unroll
                for (int bj = 0; bj < 2; ++bj) { float g[8]; unpack8(gc[ai][m][bj], g);
                    f32x4 v0 = acc[ai][bj][m][0], v1 = acc[ai][bj][m][1];
                    v0[0] *= g[0]; v0[1] *= g[1]; v0[2] *= g[2]; v0[3] *= g[3]; v1[0] *= g[4]; v1[1] *= g[5]; v1[2] *= g[6]; v1[3] *= g[7];
                    acc[ai][bj][m][0] = v0; acc[ai][bj][m][1] = v1;
                    if (fin) { u32x4 w; w.x = cvt_pk_bf16(v0[0], v0[1]); w.y = cvt_pk_bf16(v0[2], v0[3]); w.z = cvt_pk_bf16(v1[0], v1[1]); w.w = cvt_pk_bf16(v1[2], v1[3]);
                        *(u32x4*)(mb + (size_t)(row0 + ai * HALF + m * 16) * DM + col0 + bj * HALF) = w; } }
    }
};
struct EpiResid {
    static constexpr bool CARRY = false;
    bf16_t* xb; float* ss; float* outf; const float* ssin;
    __device__ __forceinline__ void operator()(AccT& acc, const Unit& u, int wr, int wc, int fr, int fq) const {
        const int row0 = u.pm * BM + wr * 64 + fr, col0 = u.pn * BM + wc * 32 + 8 * fq;
#pragma unroll
        for (int ai = 0; ai < 2; ++ai) {
            u32x4 xi[4][2]; float sc[4];
#pragma unroll
            for (int m = 0; m < 4; ++m) { sc[m] = ssin ? ssin[row0 + ai * HALF + m * 16] : 0.f;
#pragma unroll
                for (int bj = 0; bj < 2; ++bj) xi[m][bj] = *(const u32x4*)(xb + (size_t)(row0 + ai * HALF + m * 16) * DM + col0 + bj * HALF); }
#pragma unroll
            for (int m = 0; m < 4; ++m) { const int row = row0 + ai * HALF + m * 16; float s = 0.f; const float f = ssin ? __builtin_amdgcn_rcpf(sc[m] * (1.f / DM) + EPS) : 1.f;
#pragma unroll
                for (int bj = 0; bj < 2; ++bj) { const size_t off = (size_t)row * DM + col0 + bj * HALF; float xv[8]; unpack8(xi[m][bj], xv);
                    const f32x4 v0 = acc[ai][bj][m][0] * f + (f32x4){xv[0], xv[1], xv[2], xv[3]}, v1 = acc[ai][bj][m][1] * f + (f32x4){xv[4], xv[5], xv[6], xv[7]};
                    if (outf) { *(f32x4*)(outf + off) = v0; *(f32x4*)(outf + off + 4) = v1; }
                    else { u32x4 w; w.x = cvt_pk_bf16(v0[0], v0[1]); w.y = cvt_pk_bf16(v0[2], v0[3]); w.z = cvt_pk_bf16(v1[0], v1[1]); w.w = cvt_pk_bf16(v1[2], v1[3]);
                        *(u32x4*)(xb + off) = w;
                        s += (v0[0] * v0[0] + v0[1] * v0[1]) + (v0[2] * v0[2] + v0[3] * v0[3]) + (v1[0] * v1[0] + v1[1] * v1[1]) + (v1[2] * v1[2] + v1[3] * v1[3]); } }
                if (!outf) { s += __shfl_xor(s, 16); s += __shfl_xor(s, 32); if (fq == 0) atomicAdd(ss + row, s); } }
        }
    }
};
struct EpiUp {
    static constexpr bool CARRY = false;
    bf16_t* hb;
    __device__ __forceinline__ void operator()(AccT& acc, const Unit& u, int wr, int wc, int fr, int fq) const {
        const int row0 = u.pm * BM + wr * 64 + fr, col0 = u.pn * BM + wc * 32 + 8 * fq;
#pragma unroll
        for (int ai = 0; ai < 2; ++ai)
#pragma unroll
            for (int m = 0; m < 4; ++m) { const int row = row0 + ai * HALF + m * 16;
#pragma unroll
                for (int bj = 0; bj < 2; ++bj) { f32x4 v0 = acc[ai][bj][m][0], v1 = acc[ai][bj][m][1];
#pragma unroll
                    for (int j = 0; j < 4; ++j) { const float a = fmaxf(v0[j], 0.f), b = fmaxf(v1[j], 0.f); v0[j] = a * a; v1[j] = b * b; }
                    u32x4 w; w.x = cvt_pk_bf16(v0[0], v0[1]); w.y = cvt_pk_bf16(v0[2], v0[3]); w.z = cvt_pk_bf16(v1[0], v1[1]); w.w = cvt_pk_bf16(v1[2], v1[3]);
                    *(u32x4*)(hb + (size_t)row * DFF + col0 + bj * HALF) = w; } }
    }
};
struct EpiPool {
    static constexpr bool CARRY = false;
    const float* scale; bf16_t* ycat;
    __device__ __forceinline__ void operator()(AccT& acc, const Unit& u, int wr, int wc, int fr, int fq) const {
        const int row0 = u.pm * BM + wr * 64 + fr, col0 = u.pn * BM + wc * 32 + 8 * fq;
#pragma unroll
        for (int bj = 0; bj < 2; ++bj) { const int col = col0 + bj * HALF; const f32x4 s0 = *(const f32x4*)(scale + col), s1 = *(const f32x4*)(scale + col + 4);
#pragma unroll
            for (int ai = 0; ai < 2; ++ai)
#pragma unroll
                for (int m = 0; m < 4; ++m) { const int row = row0 + ai * HALF + m * 16; const f32x4 v0 = acc[ai][bj][m][0] * s0, v1 = acc[ai][bj][m][1] * s1;
                    u32x4 w; w.x = cvt_pk_bf16(v0[0], v0[1]); w.y = cvt_pk_bf16(v0[2], v0[3]); w.z = cvt_pk_bf16(v1[0], v1[1]); w.w = cvt_pk_bf16(v1[2], v1[3]);
                    *(u32x4*)(ycat + (size_t)row * DM + 512 + col) = w; } }
    }
};
struct EpiLru {
    static constexpr bool CARRY = false;
    const float* br; const float* bi; const bf16_t* ub; float* ab; float* ib;
    __device__ __forceinline__ void operator()(AccT& acc, const Unit& u, int wr, int wc, int fr, int fq) const {
        const int row0 = u.pm * BM + wr * 64 + fr;
#pragma unroll
        for (int n = 0; n < 2; ++n) { const int ch0 = u.pn * 128 + wc * 32 + 8 * fq + 4 * n;
            const f32x4 brv = *(const f32x4*)(br + ch0), biv = *(const f32x4*)(bi + ch0);
            u32x2 uws[2][4];
#pragma unroll
            for (int ai = 0; ai < 2; ++ai)
#pragma unroll
                for (int m = 0; m < 4; ++m) uws[ai][m] = *(const u32x2*)(ub + (size_t)(row0 + ai * HALF + m * 16) * 512 + ch0);
#pragma unroll
            for (int ai = 0; ai < 2; ++ai)
#pragma unroll
                for (int m = 0; m < 4; ++m) { const int row = row0 + ai * HALF + m * 16;
                    const u32x2 uw = uws[ai][m]; const f32x4 uu = (f32x4){bf_lo(uw.x), bf_hi(uw.x), bf_lo(uw.y), bf_hi(uw.y)};
                    f32x4 av, iv;
#pragma unroll
                    for (int j = 0; j < 4; ++j) { av[j] = fsigmoid(acc[ai][0][m][n][j] + brv[j]); iv[j] = fsigmoid(acc[ai][1][m][n][j] + biv[j]) * uu[j]; }
                    *(f32x4*)(ab + (size_t)row * 512 + ch0) = av; *(f32x4*)(ib + (size_t)row * 512 + ch0) = iv; } }
    }
};

template <class Epi, class Sched>
__device__ __forceinline__ void gemm_phase(LAS unsigned char* lds, const Gemm g, const Sched& S, const Epi& E) {
    int tid_ = threadIdx.x; asm volatile("" : "+v"(tid_));
    const int tid = tid_, wid = __builtin_amdgcn_readfirstlane(tid >> 6), lane = tid & 63, wr = wid >> 2, wc = wid & 3, fr = lane & 15, fq = lane >> 4;
    int K_ = g.K; asm volatile("" : "+s"(K_)); const int nt = K_ / BK;
    unsigned voffA, voffB;
    { int R, C; stage_rc(tid * 16, R, C); const int Rb = (R & ~31) + perm32(R & 31); voffA = (unsigned)(R * g.lda + C) * 2u; voffB = (unsigned)(Rb * g.ldb + C) * 2u; }
    const unsigned qoffA = 64u * (unsigned)g.lda * 2u, qoffB = 64u * (unsigned)g.ldb * 2u;
    const size_t kstep = (size_t)(BK * 2);
    const size_t hstepA = (size_t)HALF * g.lda * 2, hstepB = (size_t)HALF * g.ldb * 2, tstepA = 2 * hstepA, tstepB = 2 * hstepB;
    const unsigned ldsw = (unsigned)wid * 1024u;
    const int aoff = lds_byte(wr * 64 + fr, fq * 8), boff = lds_byte(wc * 32 + fr, fq * 8);
#define PG8_SA(b, h) (((b) * 2 + (h)) * HTB)
#define PG8_SB(b, h) ((4 + (b) * 2 + (h)) * HTB)
#define PG8_STAGE(bufoff, gbase, voff) do { _Pragma("unroll") for (int _i = 0; _i < 2; ++_i) \
        __builtin_amdgcn_global_load_lds((const unsigned*)((const char*)(gbase) + (size_t)(_i * q##voff) + (v##voff)), (LAS unsigned*)(lds + (bufoff) + ldsw + _i * 8192), 16, 0, 0); } while (0)
#define PG8_LDA(dst, b, h) do { _Pragma("unroll") for (int m = 0; m < 4; ++m) _Pragma("unroll") for (int k = 0; k < 2; ++k) dst[m][k] = *(const LAS bf16x8*)(lds + PG8_SA(b, h) + aoff + m * 2048 + k * 1024); } while (0)
#define PG8_LDB(dst, b, h) do { _Pragma("unroll") for (int n = 0; n < 2; ++n) _Pragma("unroll") for (int k = 0; k < 2; ++k) dst[n][k] = *(const LAS bf16x8*)(lds + PG8_SB(b, h) + boff + n * 2048 + k * 1024); } while (0)
#define PG8_MMA(ai, bj, At, Bt) do { __builtin_amdgcn_s_setprio(1); _Pragma("unroll") for (int m = 0; m < 4; ++m) _Pragma("unroll") for (int n = 0; n < 2; ++n) _Pragma("unroll") for (int k = 0; k < 2; ++k) \
        acc[ai][bj][m][n] = __builtin_amdgcn_mfma_f32_16x16x32_bf16(Bt[n][k], At[m][k], acc[ai][bj][m][n], 0, 0, 0); __builtin_amdgcn_s_setprio(0); } while (0)
#define PG8_WAIT_V(n) asm volatile("s_waitcnt vmcnt(" #n ")" ::: "memory")
#define PG8_WAIT_L(n) asm volatile("s_waitcnt lgkmcnt(" #n ")" ::: "memory")
#define PG8_BAR __builtin_amdgcn_s_barrier()
#define PG8_SCHED __builtin_amdgcn_sched_barrier(0)
    Unit cur, nxt; int ui = 0;
    if (!S.next(0, cur)) return;
    f32x4 acc[2][2][4][2];
#pragma unroll
    for (int a = 0; a < 2; ++a)
#pragma unroll
        for (int b = 0; b < 2; ++b)
#pragma unroll
            for (int m = 0; m < 4; ++m)
#pragma unroll
                for (int n = 0; n < 2; ++n) acc[a][b][m][n] = (f32x4){0.f, 0.f, 0.f, 0.f};
    bf16x8 At[4][2], B0[2][2], B1[2][2];
    const char* cA = (const char*)g.A + (size_t)cur.pm * tstepA + cur.koff; const char* cB = (const char*)g.Bt + (size_t)cur.pn * tstepB + cur.koff;
    PG8_STAGE(PG8_SB(0, 0), cB, offB); PG8_STAGE(PG8_SB(0, 1), cB + hstepB, offB); PG8_STAGE(PG8_SA(0, 0), cA, offA); PG8_STAGE(PG8_SA(0, 1), cA + hstepA, offA);
    if (wr == 1) PG8_BAR;
    PG8_WAIT_V(2); PG8_BAR;
    PG8_STAGE(PG8_SB(1, 0), cB + kstep, offB); PG8_STAGE(PG8_SA(1, 0), cA + kstep, offA); PG8_STAGE(PG8_SB(1, 1), cB + hstepB + kstep, offB);
    PG8_WAIT_V(6); PG8_BAR;
    for (;;) {
        const bool has_next = S.next(ui + 1, nxt);
        const char* nA = has_next ? (const char*)g.A + (size_t)nxt.pm * tstepA + nxt.koff : cA; const char* nB = has_next ? (const char*)g.Bt + (size_t)nxt.pn * tstepB + nxt.koff : cB;
        for (int t = 0; t < nt; t += 2) {
            const bool last = (t == nt - 2);
            const char* a1 = cA + (size_t)(t + 1) * kstep;
            const char* a2 = last ? nA : cA + (size_t)(t + 2) * kstep; const char* b2 = last ? nB : cB + (size_t)(t + 2) * kstep;
            const char* a3 = a2 + kstep; const char* b3 = b2 + kstep;
            PG8_LDB(B0, 0, 0); PG8_LDB(B1, 0, 1); PG8_SCHED; PG8_LDA(At, 0, 0); PG8_STAGE(PG8_SA(1, 1), a1 + hstepA, offA);
            PG8_WAIT_V(8); PG8_WAIT_L(0); PG8_BAR; PG8_MMA(0, 0, At, B0); PG8_MMA(0, 1, At, B1); PG8_BAR; PG8_SCHED;
            PG8_LDA(At, 0, 1); PG8_STAGE(PG8_SB(0, 0), b2, offB); PG8_STAGE(PG8_SB(0, 1), b2 + hstepB, offB); PG8_STAGE(PG8_SA(0, 0), a2, offA);
            PG8_WAIT_V(8); PG8_WAIT_L(0); PG8_BAR; PG8_MMA(1, 0, At, B0); PG8_MMA(1, 1, At, B1); PG8_BAR; PG8_SCHED;
            PG8_LDB(B0, 1, 0); PG8_LDB(B1, 1, 1); PG8_SCHED; PG8_LDA(At, 1, 0); PG8_STAGE(PG8_SA(0, 1), a2 + hstepA, offA);
            PG8_WAIT_V(8); PG8_WAIT_L(0); PG8_BAR; PG8_MMA(0, 0, At, B0); PG8_MMA(0, 1, At, B1); PG8_BAR; PG8_SCHED;
            PG8_LDA(At, 1, 1); PG8_STAGE(PG8_SB(1, 0), b3, offB); PG8_STAGE(PG8_SB(1, 1), b3 + hstepB, offB); PG8_STAGE(PG8_SA(1, 0), a3, offA);
            PG8_WAIT_V(8); PG8_WAIT_L(0); PG8_BAR; PG8_MMA(1, 0, At, B0); PG8_MMA(1, 1, At, B1); PG8_BAR; PG8_SCHED;
        }
        if (wr == 0) PG8_BAR;
        E(acc, cur, wr, wc, fr, fq);
        if (!has_next) break;
        if (!(Epi::CARRY && cur.ks != 3)) {
#pragma unroll
        for (int a = 0; a < 2; ++a)
#pragma unroll
            for (int b = 0; b < 2; ++b)
#pragma unroll
                for (int m = 0; m < 4; ++m)
#pragma unroll
                    for (int n = 0; n < 2; ++n) acc[a][b][m][n] = (f32x4){0.f, 0.f, 0.f, 0.f}; }
        cur = nxt; cA = nA; cB = nB; ++ui;
        if (wr == 1) PG8_BAR;
    }
    PG8_WAIT_V(0);
    PG8_BAR;
#undef PG8_SA
#undef PG8_SB
#undef PG8_STAGE
#undef PG8_LDA
#undef PG8_LDB
#undef PG8_MMA
#undef PG8_WAIT_V
#undef PG8_WAIT_L
#undef PG8_BAR
#undef PG8_SCHED
}
}

#define LDS_WAIT() asm volatile("s_waitcnt lgkmcnt(0)" ::: "memory")
__device__ __forceinline__ void tr_item64(const float* __restrict__ W, int ldw, const float* __restrict__ gk, bf16_t* WT, int ldt, LAS unsigned* scr, int lane, int gperm = -1) {
    const int c = lane & 15, rp = lane >> 4;
    f32x4 v[8][2];
#pragma unroll
    for (int i = 0; i < 8; ++i) { const int r = 4 * i + rp; v[i][0] = __builtin_nontemporal_load((const f32x4*)(W + (size_t)(2 * r) * ldw + 4 * c)); v[i][1] = __builtin_nontemporal_load((const f32x4*)(W + (size_t)(2 * r + 1) * ldw + 4 * c)); }
#pragma unroll
    for (int i = 0; i < 8; ++i) { const int r = 4 * i + rp; float g0 = 1.f, g1 = 1.f; if (gk) { g0 = gk[2 * r]; g1 = gk[2 * r + 1]; }
#pragma unroll
        for (int j = 0; j < 4; ++j) scr[(4 * c + j) * 33 + r] = cvt_pk_bf16(v[i][0][j] * g0, v[i][1][j] * g1); }
    LDS_WAIT(); asm volatile("" ::: "memory");
#pragma unroll
    for (int i = 0; i < 8; ++i) { const int n = 8 * i + (lane >> 3), q = lane & 7; const LAS unsigned* sp = scr + n * 33 + 4 * q;
        const int nr = gperm < 0 ? n : 128 * (gperm >> 1) + 32 * ((n >> 4) & 3) + 8 * ((n >> 2) & 3) + 4 * (gperm & 1) + (n & 3);
        u32x4 o; o.x = sp[0]; o.y = sp[1]; o.z = sp[2]; o.w = sp[3]; *(u32x4*)(WT + (size_t)nr * ldt + 8 * q) = o; }
    LDS_WAIT(); asm volatile("" ::: "memory");
}

struct Args { const float* in[21]; float* out; unsigned char* ws; int ph_lo, ph_hi; };

__device__ __forceinline__ void prologue(const Args& a, LAS unsigned char* lds, int gw, int NGW, int lane, int gtid, int NT) {
    unsigned char* ws = a.ws;
    LAS unsigned* scr = (LAS unsigned*)(lds + (gw & 7) * 16384);
    constexpr int I_IN = 32 * 192, I_WB = 8 * 32, I_WO = 32 * 32, I_UP = 32 * 128, I_DN = 128 * 32;
    constexpr int N0 = 2 * I_IN, N1 = N0 + 8 * I_WB, N2 = N1 + 2 * I_WO, N3 = N2 + 2 * I_UP, N4 = N3 + 2 * I_DN, N5 = N4 + 32, N6 = N5 + 32;
    for (int it = gw; it < N6; it += NGW) {
        if (it < N0) { const int l = it / I_IN, r = it % I_IN, kb = r / 192, nb = r % 192, n0 = nb * 64, sc = n0 + (n0 >= 4096 ? 8 : 0);
            const int gperm = n0 >= 4096 ? (n0 - 4096) >> 11 : -1, nd = n0 >= 4096 ? 4096 + 256 * (((n0 - 4096) & 2047) >> 6) : n0;
            tr_item64(a.in[2] + ((size_t)l * DM + kb * 64) * NIN_SRC + sc, NIN_SRC, a.in[1] + l * DM + kb * 64, (bf16_t*)(ws + WS_WIN) + ((size_t)l * NIN + nd) * DM + kb * 64, DM, scr, lane, gperm); }
        else if (it < N1) { const int r0 = it - N0, lk = r0 / I_WB, r = r0 % I_WB, l = lk >> 2, kbr = lk & 3, kb = r / 32, nb = r % 32;
            tr_item64(a.in[16] + ((size_t)lk * 512 + kb * 64) * DM + nb * 64, DM, nullptr, (bf16_t*)(ws + WS_WB) + ((size_t)l * DM + nb * 64) * DM + kbr * 512 + kb * 64, DM, scr, lane); }
        else if (it < N2) { const int r0 = it - N1, l = r0 / I_WO, r = r0 % I_WO, kb = r / 32, nb = r % 32;
            tr_item64(a.in[17] + ((size_t)l * DM + kb * 64) * DM + nb * 64, DM, nullptr, (bf16_t*)(ws + WS_WO) + ((size_t)l * DM + nb * 64) * DM + kb * 64, DM, scr, lane); }
        else if (it < N3) { const int r0 = it - N2, l = r0 / I_UP, r = r0 % I_UP, kb = r / 128, nb = r % 128;
            tr_item64(a.in[19] + ((size_t)l * DM + kb * 64) * DFF + nb * 64, DFF, a.in[18] + l * DM + kb * 64, (bf16_t*)(ws + WS_WUP) + ((size_t)l * DFF + nb * 64) * DM + kb * 64, DM, scr, lane); }
        else if (it < N4) { const int r0 = it - N3, l = r0 / I_DN, r = r0 % I_DN, kb = r / 32, nb = r % 32;
            tr_item64(a.in[20] + ((size_t)l * DFF + kb * 64) * DM + nb * 64, DM, nullptr, (bf16_t*)(ws + WS_WDN) + ((size_t)l * DM + nb * 64) * DFF + kb * 64, DFF, scr, lane); }
        else if (it < N5) { const int r0 = it - N4, lg = r0 >> 2, r = r0 & 3, l = lg >> 2, g = lg & 3, kb = r >> 1, nb = r & 1;
            tr_item64(a.in[10] + ((size_t)lg * 128 + kb * 64) * 128 + nb * 64, 128, nullptr, (bf16_t*)(ws + WS_WPOOL) + ((size_t)l * 512 + g * 128 + nb * 64) * 512 + g * 128 + kb * 64, 512, scr, lane); }
        else { const int r0 = it - N5, h = r0 & 7, mat = (r0 >> 3) & 1, l = r0 >> 4;
            tr_item64(a.in[mat ? 7 : 5] + ((size_t)(l * 8 + h) * 64) * 64, 64, nullptr, (bf16_t*)(ws + WS_WLRU) + ((size_t)l * 1024 + (h >> 1) * 256 + mat * 128 + (h & 1) * 64) * 512 + h * 64, 512, scr, lane); }
    }
    for (int i = gtid; i < 2 * 512 * 16; i += NT) { const int l = i / 8192, r = (i % 8192) / 16, ch = i % 16, og = (r >> 7) ^ 1;
        *(u32x4*)((bf16_t*)(ws + WS_WPOOL) + ((size_t)l * 512 + r) * 512 + og * 128 + ch * 8) = (u32x4){0u, 0u, 0u, 0u}; }
    for (int i = gtid; i < 2 * 1024 * 8; i += NT) { const int l = i / 8192, r = (i % 8192) / 8, ch = i % 8, h = 2 * (r >> 8) + ((r & 127) >> 6), oh = h ^ 1;
        *(u32x4*)((bf16_t*)(ws + WS_WLRU) + ((size_t)l * 1024 + r) * 512 + oh * 64 + ch * 8) = (u32x4){0u, 0u, 0u, 0u}; }
    for (int i = gtid; i < 2 * 8 * DM; i += NT) { const int l = i / (8 * DM), h = (i / DM) & 7, k = i % DM;
        ((float*)(ws + WS_WF))[i] = a.in[1][l * DM + k] * a.in[2][((size_t)l * DM + k) * NIN_SRC + 4096 + h]; }
    for (int i = gtid; i < 4 * T; i += NT) ((float*)(ws + WS_SS))[T + i] = 0.f;
    for (int m0 = gw; m0 < T; m0 += 4 * NGW) { f32x4 v[4][8];
#pragma unroll
        for (int q = 0; q < 4; ++q) { const int m = (m0 + q * NGW < T) ? m0 + q * NGW : m0; const f32x4* xr = (const f32x4*)(a.in[0] + (size_t)m * DM) + lane;
#pragma unroll
            for (int j = 0; j < 8; ++j) v[q][j] = __builtin_nontemporal_load(xr + 64 * j); }
#pragma unroll
        for (int q = 0; q < 4; ++q) { const int m = m0 + q * NGW; if (m < T) { float s = 0.f; u32x2* o8 = (u32x2*)((bf16_t*)(ws + WS_XB) + (size_t)m * DM) + lane;
#pragma unroll
            for (int j = 0; j < 8; ++j) { const f32x4 x = v[q][j]; s += (x.x * x.x + x.y * x.y) + (x.z * x.z + x.w * x.w); u32x2 w; w.x = cvt_pk_bf16(x.x, x.y); w.y = cvt_pk_bf16(x.z, x.w); o8[64 * j] = w; }
            s = wave_sum(s); if (lane == 0) ((float*)(ws + WS_SS))[m] = s; } } }
}

__device__ __forceinline__ void flogit_phase(const bf16_t* xb, const float* wf, const float* ss, const float* fb, float* logf, int gw, int NGW, int lane) {
    for (int tq = gw; tq < T / 4; tq += NGW) {
        float acc[4][8];
#pragma unroll
        for (int j = 0; j < 4; ++j)
#pragma unroll
            for (int h = 0; h < 8; ++h) acc[j][h] = 0.f;
#pragma unroll
        for (int ci = 0; ci < 4; ++ci) { const int col = ci * 512 + lane * 8; float xv[4][8];
#pragma unroll
            for (int j = 0; j < 4; ++j) unpack8(*(const u32x4*)(xb + (size_t)(4 * tq + j) * DM + col), xv[j]);
#pragma unroll
            for (int h = 0; h < 8; ++h) { const f32x4 w0 = *(const f32x4*)(wf + h * DM + col), w1 = *(const f32x4*)(wf + h * DM + col + 4);
#pragma unroll
                for (int j = 0; j < 4; ++j) acc[j][h] += (xv[j][0] * w0[0] + xv[j][1] * w0[1]) + (xv[j][2] * w0[2] + xv[j][3] * w0[3]) + (xv[j][4] * w1[0] + xv[j][5] * w1[1]) + (xv[j][6] * w1[2] + xv[j][7] * w1[3]); } }
        float mine = 0.f;
#pragma unroll
        for (int j = 0; j < 4; ++j)
#pragma unroll
            for (int h = 0; h < 8; ++h) { const float v = wave_sum(acc[j][h]); if (lane == j * 8 + h) mine = v; }
        if (lane < 32) { const int t = 4 * tq + (lane >> 3), hh = lane & 7; const float z = mine * __builtin_amdgcn_rsqf(ss[t] * (1.f / DM) + EPS) + fb[hh];
            logf[t * 8 + hh] = fminf(z, 0.f) - log1pf(__expf(-fabsf(z))); }
    }
}

template <int WIN> __device__ __forceinline__ void pool_load(const bf16_t* proj, u32x4 (&w)[WIN], int t, int c, int s) {
    const int cnt = (s + 1 < WIN) ? s + 1 : WIN;
#pragma unroll
    for (int k = 0; k < WIN; ++k) w[k] = *(const u32x4*)(proj + (size_t)(k < cnt ? t - k : t) * 4096 + 512 + c);
}
template <int WIN> __device__ __forceinline__ void pool_finish(const u32x4 (&w)[WIN], bf16_t* pooled, int t, int c, int s) {
    const int cnt = (s + 1 < WIN) ? s + 1 : WIN;
    float acc[8], x0[8]; unpack8(w[0], x0);
#pragma unroll
    for (int j = 0; j < 8; ++j) acc[j] = x0[j];
#pragma unroll
    for (int k = 1; k < WIN; ++k) { float xv[8]; unpack8(w[k], xv); const float wt = k < cnt ? 1.f : 0.f;
#pragma unroll
        for (int j = 0; j < 8; ++j) acc[j] += wt * xv[j]; }
    const float inv = 1.f / (float)cnt;
#pragma unroll
    for (int j = 0; j < 8; ++j) acc[j] = acc[j] * inv - x0[j];
    *(u32x4*)(pooled + (size_t)t * 512 + c) = pack8(acc);
}
__device__ __forceinline__ void mixer_elementwise(const bf16_t* proj, const float* cw, const float* cb, const float* sw, bf16_t* ub, bf16_t* pooled, bf16_t* ycat, int gtid, int NT) {
    {
        const int c = (gtid & 63) * 8;
        float cwv[4][8], cbv[8], swv[3][8];
#pragma unroll
        for (int j = 0; j < 8; ++j) { cbv[j] = cb[c + j];
#pragma unroll
            for (int k = 0; k < 4; ++k) cwv[k][j] = cw[k * 512 + c + j];
#pragma unroll
            for (int k = 0; k < 3; ++k) swv[k][j] = sw[k * 512 + c + j]; }
        for (int i0 = gtid; i0 < T * 64; i0 += 2 * NT) {
            u32x4 xa[2][4], gc[2][3], xc[2][3], gbw[2];
#pragma unroll
            for (int h = 0; h < 2; ++h) { const int i = (i0 + h * NT < T * 64) ? i0 + h * NT : i0, t = i >> 6, sq = t & (SEQ - 1);
#pragma unroll
                for (int k = 0; k < 4; ++k) xa[h][k] = *(const u32x4*)(proj + (size_t)(sq - 3 + k >= 0 ? t - 3 + k : t) * 4096 + c);
#pragma unroll
                for (int k = 0; k < 3; ++k) { const bf16_t* p = proj + (size_t)(sq - 2 + k >= 0 ? t - 2 + k : t) * 4096; gc[h][k] = *(const u32x4*)(p + 1536 + c); xc[h][k] = *(const u32x4*)(p + 2048 + c); }
                gbw[h] = *(const u32x4*)(proj + (size_t)t * 4096 + 1024 + c); }
#pragma unroll
            for (int h = 0; h < 2; ++h) { const int i = (i0 + h * NT < T * 64) ? i0 + h * NT : i0, t = i >> 6, sq = t & (SEQ - 1);
                float acc[8], ac2[8];
#pragma unroll
                for (int j = 0; j < 8; ++j) { acc[j] = cbv[j]; ac2[j] = 0.f; }
#pragma unroll
                for (int k = 0; k < 4; ++k) { float xv[8]; unpack8(xa[h][k], xv); const float wt = (sq - 3 + k >= 0) ? 1.f : 0.f;
#pragma unroll
                    for (int j = 0; j < 8; ++j) acc[j] += wt * cwv[k][j] * xv[j]; }
                *(u32x4*)(ub + (size_t)t * 512 + c) = pack8(acc);
#pragma unroll
                for (int k = 0; k < 3; ++k) { float g8[8], x8[8]; unpack8(gc[h][k], g8); unpack8(xc[h][k], x8); const float wt = (sq - 2 + k >= 0) ? 1.f : 0.f;
#pragma unroll
                    for (int j = 0; j < 8; ++j) ac2[j] += wt * swv[k][j] * (g8[j] * x8[j]); }
                float gb8[8]; unpack8(gbw[h], gb8);
#pragma unroll
                for (int j = 0; j < 8; ++j) ac2[j] *= gb8[j];
                *(u32x4*)(ycat + (size_t)t * DM + 1024 + c) = pack8(ac2); }
        }
    }
    for (int i = gtid; i < T * 16; i += NT) { const int t = i >> 4, cc = (i & 15) * 8, sq = t & (SEQ - 1);
        u32x4 w2[2], w4[4], w8[8], w16[16];
        pool_load<2>(proj, w2, t, cc, sq); pool_load<4>(proj, w4, t, 128 + cc, sq); pool_load<8>(proj, w8, t, 256 + cc, sq); pool_load<16>(proj, w16, t, 384 + cc, sq);
        pool_finish<2>(w2, pooled, t, cc, sq); pool_finish<4>(w4, pooled, t, 128 + cc, sq); pool_finish<8>(w8, pooled, t, 256 + cc, sq); pool_finish<16>(w16, pooled, t, 384 + cc, sq); }
}

typedef short v4i16_t __attribute__((ext_vector_type(4)));
constexpr int AT_K = 0, AT_V = 9216, AT_BIAS = 18432, AT_WS = 26624, AT_PITCH = 144;
__device__ __forceinline__ void attn_unit(LAS unsigned char* lds, int b, int h, int qblk, const bf16_t* proj, const float* logf, const float* qg, const float* kg, bf16_t* ycat) {
    int tid_ = threadIdx.x; asm volatile("" : "+v"(tid_));
    const int tid = tid_, wid = __builtin_amdgcn_readfirstlane(tid >> 6), lane = tid & 63, li = lane & 15, g = lane >> 4;
    LAS float* bias = (LAS float*)(lds + AT_BIAS); LAS float* wsum = (LAS float*)(lds + AT_WS);
    const int qrow = b * SEQ + qblk * 128 + wid * 16 + li;
    const int srow = tid >> 3, sch = tid & 7;
    const bf16_t* kvp = proj + (size_t)(b * SEQ + srow) * 4096 + h * 64 + sch * 8;
    const bf16_t* qp = proj + (size_t)qrow * 4096 + 2560 + h * 64 + 8 * g;
    float lf[4];
#pragma unroll
    for (int j = 0; j < 4; ++j) lf[j] = logf[(size_t)(b * SEQ + 4 * tid + j) * 8 + h];
    const u32x4 qw0 = *(const u32x4*)qp, qw1 = *(const u32x4*)(qp + 32);
    const f32x4 qga = *(const f32x4*)(qg + 8 * g), qgb = *(const f32x4*)(qg + 8 * g + 4), qgc = *(const f32x4*)(qg + 32 + 8 * g), qgd = *(const f32x4*)(qg + 32 + 8 * g + 4);
    const f32x4 kga = *(const f32x4*)(kg + sch * 8), kgb = *(const f32x4*)(kg + sch * 8 + 4);
    u32x4 kreg = *(const u32x4*)(kvp + 3072), vreg = *(const u32x4*)(kvp + 3584);
    __syncthreads();
    {
        float v[4]; float run = 0.f;
#pragma unroll
        for (int j = 0; j < 4; ++j) { run += lf[j]; v[j] = run; }
        float incl = run;
#pragma unroll
        for (int o = 1; o < 64; o <<= 1) { const float n = __shfl_up(incl, o); if (lane >= o) incl += n; }
        if (lane == 63) wsum[wid] = incl;
        __syncthreads();
        float off = incl - run;
        for (int w = 0; w < wid; ++w) off += wsum[w];
#pragma unroll
        for (int j = 0; j < 4; ++j) bias[4 * tid + j] = -(off + v[j]) * LOG2E;
    }
    bf16x8 qf[2];
    {
        float q0[8], q1[8]; unpack8(qw0, q0); unpack8(qw1, q1);
        const float qg0[8] = {qga[0], qga[1], qga[2], qga[3], qgb[0], qgb[1], qgb[2], qgb[3]}, qg1[8] = {qgc[0], qgc[1], qgc[2], qgc[3], qgd[0], qgd[1], qgd[2], qgd[3]};
        float s = 0.f;
#pragma unroll
        for (int j = 0; j < 8; ++j) s += q0[j] * q0[j] + q1[j] * q1[j];
        s += __shfl_xor(s, 16); s += __shfl_xor(s, 32);
        const float rq = __builtin_amdgcn_rsqf(s * (1.f / 64.f) + EPS) * (0.125f * LOG2E);
#pragma unroll
        for (int j = 0; j < 8; ++j) { q0[j] *= rq * qg0[j]; q1[j] *= rq * qg1[j]; }
        const u32x4 w0 = pack8(q0), w1 = pack8(q1); qf[0] = __builtin_bit_cast(bf16x8, w0); qf[1] = __builtin_bit_cast(bf16x8, w1);
    }
    const float kgv[8] = {kga[0], kga[1], kga[2], kga[3], kgb[0], kgb[1], kgb[2], kgb[3]};
    const int ntiles = 2 * (qblk + 1);
    const int qbase = qblk * 128 + wid * 16;
    f32x4 oacc[4];
#pragma unroll
    for (int d = 0; d < 4; ++d) oacc[d] = (f32x4){0.f, 0.f, 0.f, 0.f};
    float mrun = -INFINITY, lsum = 0.f;
    for (int kt = 0; kt < ntiles; ++kt) {
        __syncthreads();
        {
            float kv[8]; unpack8(kreg, kv); float s = 0.f;
#pragma unroll
            for (int j = 0; j < 8; ++j) s += kv[j] * kv[j];
            s += __shfl_xor(s, 1); s += __shfl_xor(s, 2); s += __shfl_xor(s, 4);
            const float rk = __builtin_amdgcn_rsqf(s * (1.f / 64.f) + EPS);
#pragma unroll
            for (int j = 0; j < 8; ++j) kv[j] *= rk * kgv[j];
            *(LAS u32x4*)(lds + AT_K + srow * AT_PITCH + sch * 16) = pack8(kv);
            *(LAS u32x4*)(lds + AT_V + srow * AT_PITCH + sch * 16) = vreg;
        }
        __syncthreads();
        if (kt + 1 < ntiles) { const bf16_t* p = kvp + (size_t)(kt + 1) * 64 * 4096; kreg = *(const u32x4*)(p + 3072); vreg = *(const u32x4*)(p + 3584); }
        if (kt * 64 <= qbase) {
            f32x4 sacc[4];
#pragma unroll
            for (int t4 = 0; t4 < 4; ++t4) sacc[t4] = *(const LAS f32x4*)(bias + kt * 64 + 16 * t4 + 4 * g);
#pragma unroll
            for (int ks = 0; ks < 2; ++ks)
#pragma unroll
                for (int t4 = 0; t4 < 4; ++t4) { const bf16x8 kf = *(const LAS bf16x8*)(lds + AT_K + (16 * t4 + li) * AT_PITCH + ks * 64 + g * 16);
                    sacc[t4] = __builtin_amdgcn_mfma_f32_16x16x32_bf16(kf, qf[ks], sacc[t4], 0, 0, 0); }
            if (kt * 64 + 63 > qbase) {
#pragma unroll
                for (int t4 = 0; t4 < 4; ++t4)
#pragma unroll
                    for (int r = 0; r < 4; ++r) if (kt * 64 + 16 * t4 + 4 * g + r > qbase + li) sacc[t4][r] = -INFINITY;
            }
            float mx = sacc[0][0];
#pragma unroll
            for (int t4 = 0; t4 < 4; ++t4)
#pragma unroll
                for (int r = 0; r < 4; ++r) mx = fmaxf(mx, sacc[t4][r]);
            mx = fmaxf(mx, __shfl_xor(mx, 16)); mx = fmaxf(mx, __shfl_xor(mx, 32));
            const float mnew = fmaxf(mrun, mx), alpha = __builtin_amdgcn_exp2f(mrun - mnew);
            mrun = mnew; float ps = 0.f;
#pragma unroll
            for (int t4 = 0; t4 < 4; ++t4)
#pragma unroll
                for (int r = 0; r < 4; ++r) { const float p = __builtin_amdgcn_exp2f(sacc[t4][r] - mnew); sacc[t4][r] = p; ps += p; }
            lsum = lsum * alpha + ps;
#pragma unroll
            for (int d = 0; d < 4; ++d) oacc[d] *= alpha;
            bf16x8 pf[2];
#pragma unroll
            for (int kb = 0; kb < 2; ++kb) { u32x4 w; w.x = cvt_pk_bf16(sacc[2 * kb][0], sacc[2 * kb][1]); w.y = cvt_pk_bf16(sacc[2 * kb][2], sacc[2 * kb][3]);
                w.z = cvt_pk_bf16(sacc[2 * kb + 1][0], sacc[2 * kb + 1][1]); w.w = cvt_pk_bf16(sacc[2 * kb + 1][2], sacc[2 * kb + 1][3]); pf[kb] = __builtin_bit_cast(bf16x8, w); }
#pragma unroll
            for (int kb = 0; kb < 2; ++kb)
#pragma unroll
                for (int d = 0; d < 4; ++d) {
                    LAS unsigned char* vp = lds + AT_V + (32 * kb + 4 * g + (li >> 2)) * AT_PITCH + (16 * d + 4 * (li & 3)) * 2;
                    const v4i16_t t0 = __builtin_amdgcn_ds_read_tr16_b64_v4i16((LAS v4i16_t*)vp);
                    const v4i16_t t1 = __builtin_amdgcn_ds_read_tr16_b64_v4i16((LAS v4i16_t*)(vp + 16 * AT_PITCH));
                    bf16x8 vf; vf[0] = t0[0]; vf[1] = t0[1]; vf[2] = t0[2]; vf[3] = t0[3]; vf[4] = t1[0]; vf[5] = t1[1]; vf[6] = t1[2]; vf[7] = t1[3];
                    oacc[d] = __builtin_amdgcn_mfma_f32_16x16x32_bf16(vf, pf[kb], oacc[d], 0, 0, 0); }
        }
    }
    lsum += __shfl_xor(lsum, 16); lsum += __shfl_xor(lsum, 32);
    const float inv = 1.f / lsum;
    bf16_t* op = ycat + (size_t)qrow * DM + 1536 + h * 64 + 4 * g;
#pragma unroll
    for (int d = 0; d < 4; ++d) { u32x2 w; w.x = cvt_pk_bf16(oacc[d][0] * inv, oacc[d][1] * inv); w.y = cvt_pk_bf16(oacc[d][2] * inv, oacc[d][3] * inv); *(u32x2*)(op + 16 * d) = w; }
}

__device__ __forceinline__ void lru_ai(float r, float gu, float sp8, float& a, float& x) {
    const float la = r * sp8, x2 = 2.f * la; a = __expf(la);
    const float om = (x2 > -0.05f) ? -x2 * (1.f + x2 * (0.5f + x2 * (1.f / 6.f + x2 * (1.f / 24.f + x2 * (1.f / 120.f))))) : 1.f - __expf(x2);
    x = sqrtf(fmaxf(om, 0.f)) * gu;
}
__device__ __forceinline__ void scan_unit(LAS unsigned char* lds, int unit, const float* rb, const float* gb, const float* lam, bf16_t* ycat) {
    int tid_ = threadIdx.x; asm volatile("" : "+v"(tid_));
    const int tid = tid_, seg = tid >> 3, cl = tid & 7, b = unit >> 6, ch = (unit & 63) * 8 + cl;
    LAS float* LA = (LAS float*)lds + tid; LAS float* LX = LA + 32 * 512;
    LAS float* sA = (LAS float*)(lds + 131072); LAS float* sH = sA + 512;
    const size_t base = ((size_t)b * SEQ + seg * 32) * 512 + ch;
    __syncthreads();
#pragma unroll
    for (int i = 0; i < 32; ++i) { LA[i * 512] = rb[base + (size_t)i * 512]; LX[i * 512] = gb[base + (size_t)i * 512]; }
    const float sp8 = -8.f * log1pf(__expf(-lam[ch]));
    float A = 1.f, H = 0.f;
#pragma unroll 2
    for (int i = 0; i < 32; ++i) { float a, x; lru_ai(LA[i * 512], LX[i * 512], sp8, a, x); LA[i * 512] = a; LX[i * 512] = x; H = a * H + x; A *= a; }
    sA[seg * 8 + cl] = A; sH[seg * 8 + cl] = H;
    __syncthreads();
    float hc = 0.f;
    for (int s2 = 0; s2 < seg; ++s2) hc = sA[s2 * 8 + cl] * hc + sH[s2 * 8 + cl];
    bf16_t* yp = ycat + ((size_t)b * SEQ + seg * 32) * DM + ch;
#pragma unroll 4
    for (int i = 0; i < 32; ++i) { hc = LA[i * 512] * hc + LX[i * 512]; yp[(size_t)i * DM] = (bf16_t)(cvt_pk_bf16(hc, 0.f) & 0xffffu); }
}

#define XB_TMO      128
#define XB_XCNT(j)  (256  + 64 * (j))
#define XB_XSUB(j)  (1280 + 64 * (j))
#define XB_XGEN(j)  (2304 + 64 * (j))
#define XB_TOP      3328
#define XB_TOPGEN   3392
#define XCD_BAR_WORDS 3456
#define XB_SPIN_CAP (1u << 18)
__device__ __forceinline__ unsigned xb_ld(unsigned* p)              { return __hip_atomic_load(p, __ATOMIC_RELAXED, __HIP_MEMORY_SCOPE_AGENT); }
__device__ __forceinline__ unsigned xb_add(unsigned* p, unsigned v) { return __hip_atomic_fetch_add(p, v, __ATOMIC_RELAXED, __HIP_MEMORY_SCOPE_AGENT); }
__device__ __forceinline__ unsigned xb_xcc_id() { return (unsigned)__builtin_amdgcn_s_getreg((3 << 11) | 20) & 0xFu; }
#define XB_SPIN(cond, bar) do { unsigned _sp = 0; while (cond) { __builtin_amdgcn_s_sleep(1); \
    if ((++_sp & 255u) == 0u) { if (xb_ld(&(bar)[XB_TMO])) break; if (_sp > XB_SPIN_CAP) { atomicAdd(&(bar)[XB_TMO], 1u); break; } } } } while (0)
struct XcdBarrier { unsigned* bar; unsigned x; volatile LAS unsigned* st; };
__device__ __forceinline__ void xcd_barrier_complete(unsigned* bar, unsigned x, unsigned& nloc, unsigned& nx) {
    const unsigned G = gridDim.x * gridDim.y * gridDim.z;
    unsigned sum, cnt, mine, sp = 0u;
    for (;;) {
        sum = 0u; cnt = 0u; mine = 0u;
#pragma unroll
        for (unsigned j = 0; j < 16; ++j) { const unsigned c = xb_ld(&bar[XB_XCNT(j)]); sum += c; cnt += (c > 0u) ? 1u : 0u; mine = (j == x) ? c : mine; }
        if (sum == G) break;
        __builtin_amdgcn_s_sleep(1);
        if ((++sp & 255u) == 0u) { if (xb_ld(&bar[XB_TMO])) break; if (sp > XB_SPIN_CAP) { atomicAdd(&bar[XB_TMO], 1u); break; } }
    }
    nloc = mine > 0u ? mine : 1u; nx = cnt > 0u ? cnt : 1u;
}
__device__ __forceinline__ void xcd_barrier(const XcdBarrier& b) {
    asm volatile("s_waitcnt vmcnt(0)" ::: "memory");
    __syncthreads();
    if (threadIdx.x == 0) {
        unsigned* bar = b.bar;
        __builtin_amdgcn_s_waitcnt(0);
        unsigned nloc = b.st[0], nx = b.st[1];
        if (nloc == 0u) { xcd_barrier_complete(bar, b.x, nloc, nx); b.st[0] = nloc; b.st[1] = nx; }
        const unsigned old = xb_add(&bar[XB_XSUB(b.x)], 1u);
        const unsigned gen = old / nloc;
        if (old + 1u == (gen + 1u) * nloc) {
            __builtin_amdgcn_fence(__ATOMIC_RELEASE, "agent");
            asm volatile("s_waitcnt vmcnt(0)" ::: "memory");
            const unsigned og = xb_add(&bar[XB_TOP], 1u);
            const unsigned tg = og / nx;
            if (og + 1u == (tg + 1u) * nx) xb_add(&bar[XB_TOPGEN], 1u);
            else XB_SPIN(xb_ld(&bar[XB_TOPGEN]) == tg, bar);
            __builtin_amdgcn_fence(__ATOMIC_ACQUIRE, "agent");
            xb_add(&bar[XB_XGEN(b.x)], 1u);
            asm volatile("s_waitcnt vmcnt(0)" ::: "memory");
        } else {
            XB_SPIN(xb_ld(&bar[XB_XGEN(b.x)]) == gen, bar);
            __builtin_amdgcn_fence(__ATOMIC_ACQUIRE, "agent");
            asm volatile("s_waitcnt vmcnt(0)" ::: "memory");
        }
    }
    __syncthreads();
}
constexpr size_t WS_BAR = 512 * 1024;
constexpr int LDS_BARST = LDS_BYTES - 64;

constexpr int NPHASE = 17;
__global__ void __launch_bounds__(512, 2) fwd_megakernel(Args args) {
    extern __shared__ __attribute__((aligned(16))) unsigned char lds_raw[];
    LAS unsigned char* lds = (LAS unsigned char*)lds_raw;
    cg::grid_group grid = cg::this_grid();
    const int G = gridDim.x, c = blockIdx.x, NGW = G * 8, NT = G * 512;
    const int lo = args.ph_lo, hi = args.ph_hi;
    if (threadIdx.x == 0) { ((volatile LAS unsigned*)(lds + LDS_BARST))[0] = 0u; ((volatile LAS unsigned*)(lds + LDS_BARST))[1] = 0u; (void)xb_add((unsigned*)(args.ws + WS_BAR) + XB_XCNT(xb_xcc_id()), 1u); }
    __syncthreads();
#define PHASE_PTRS(l) \
    const Args* ap = (const Args*)__builtin_amdgcn_kernarg_segment_ptr(); int lq = (l); asm volatile("" : "+s"(ap), "+s"(lq)); \
    int tidq = threadIdx.x; asm volatile("" : "+v"(tidq)); const int lane = tidq & 63, gw = c * 8 + (tidq >> 6), gtid = c * 512 + tidq; (void)lane; (void)gw; (void)gtid; \
    unsigned char* ws = ap->ws; \
    float* ss = (float*)(ws + WS_SS); float* logf = (float*)(ws + WS_LOGF); \
    bf16_t* xb = (bf16_t*)(ws + WS_XB); float* xres = (float*)(ws + WS_XRES); bf16_t* proj = (bf16_t*)(ws + WS_PROJ); bf16_t* gates = (bf16_t*)(ws + WS_GATES); bf16_t* hbuf = (bf16_t*)(ws + WS_HBUF); \
    bf16_t* ycat = (bf16_t*)(ws + WS_YCAT); float* mf32 = (float*)(ws + WS_MF32); bf16_t* mb = (bf16_t*)(ws + WS_MB); bf16_t* ub = (bf16_t*)(ws + WS_U); bf16_t* pooled = (bf16_t*)(ws + WS_POOLED); \
    float* abuf = (float*)(ws + WS_A); float* ibuf = (float*)(ws + WS_INP); \
    (void)ss; (void)logf; (void)xb; (void)xres; (void)proj; (void)gates; (void)hbuf; (void)ycat; (void)mf32; (void)mb; (void)ub; (void)pooled; (void)abuf; (void)ibuf;
#define IN(k) (lo <= (k) && (k) < hi)
#define SEAM(k) do { if (IN(k) && IN((k) + 1)) { XcdBarrier xb_; { const Args* ap_ = (const Args*)__builtin_amdgcn_kernarg_segment_ptr(); asm volatile("" : "+s"(ap_)); xb_.bar = (unsigned*)(ap_->ws + WS_BAR); } \
        xb_.x = xb_xcc_id(); xb_.st = (volatile LAS unsigned*)(lds + LDS_BARST); xcd_barrier(xb_); } } while (0)

    if (IN(0)) { PHASE_PTRS(0) prologue(*ap, lds, gw, NGW, lane, gtid, NT); __syncthreads(); }
    if (lo < 0) grid.sync();
    SEAM(0);
    for (int l = 0; l < NLAYER; ++l) {
        const int p0 = 1 + 8 * l;
        if (IN(p0)) { PHASE_PTRS(l)
            flogit_phase(xb, (const float*)(ws + WS_WF) + lq * 8 * DM, ss + (2 * lq) * T, ap->in[15] + lq * 8, logf, gw, NGW, lane);
            __syncthreads();
            pg8::Gemm g{xb, (const bf16_t*)(ws + WS_WIN) + (size_t)lq * NIN * DM, DM, DM, DM}; pg8::SchedStd S; S.so.init(T, NIN, G, c);
            pg8::EpiInProj E{ss + (2 * lq) * T, proj, gates};
            pg8::gemm_phase(lds, g, S, E);
        }
        SEAM(p0);
        if (IN(p0 + 1)) { PHASE_PTRS(l)
            mixer_elementwise(proj, ap->in[3] + lq * 4 * 512, ap->in[4] + lq * 512, ap->in[12] + lq * 3 * 512, ub, pooled, ycat, gtid, NT);
            for (int i = 0;; ++i) { const int idx = c + G * i; if (idx >= 512) break; const int bh = idx & 31, z = idx >> 5, qblk = (z < 8) ? 15 - z : z - 8;
                attn_unit(lds, bh >> 3, bh & 7, qblk, proj, logf, ap->in[13] + lq * 64, ap->in[14] + lq * 64, ycat); }
            __syncthreads();
        }
        SEAM(p0 + 1);
        if (IN(p0 + 2)) { PHASE_PTRS(l)
            { pg8::Gemm g{pooled, (const bf16_t*)(ws + WS_WPOOL) + (size_t)lq * 512 * 512, 512, 512, 256}; pg8::SchedSmall S{32, 2, G, c, 0, 512u}; pg8::EpiPool E{ap->in[11] + lq * 512, ycat}; pg8::gemm_phase(lds, g, S, E); }
            { pg8::Gemm g{ub, (const bf16_t*)(ws + WS_WLRU) + (size_t)lq * 1024 * 512, 512, 512, 128}; pg8::SchedSmall S{32, 4, G, c, 64 % G, 256u};
              pg8::EpiLru E{ap->in[6] + lq * 512, ap->in[8] + lq * 512, ub, abuf, ibuf}; pg8::gemm_phase(lds, g, S, E); }
        }
        SEAM(p0 + 2);
        if (IN(p0 + 3)) { PHASE_PTRS(l) for (int u = c; u < 256; u += G) scan_unit(lds, u, abuf, ibuf, ap->in[9] + lq * 512, ycat); __syncthreads(); }
        SEAM(p0 + 3);
        if (IN(p0 + 4)) { PHASE_PTRS(l) pg8::Gemm g{ycat, (const bf16_t*)(ws + WS_WB) + (size_t)lq * DM * DM, DM, DM, 512}; pg8::SchedSeg S; S.so.init(T, DM, G, c); S.nseg = 4; S.segbytes = 1024u;
            pg8::EpiBranch E{gates, mb}; pg8::gemm_phase(lds, g, S, E); }
        SEAM(p0 + 4);
        if (IN(p0 + 5)) { PHASE_PTRS(l) pg8::Gemm g{mb, (const bf16_t*)(ws + WS_WO) + (size_t)lq * DM * DM, DM, DM, DM}; pg8::SchedStd S; S.so.init(T, DM, G, c);
            pg8::EpiResid E{xb, ss + (2 * lq + 1) * T, nullptr, nullptr}; pg8::gemm_phase(lds, g, S, E); }
        SEAM(p0 + 5);
        if (IN(p0 + 6)) { PHASE_PTRS(l) pg8::Gemm g{xb, (const bf16_t*)(ws + WS_WUP) + (size_t)lq * DFF * DM, DM, DM, DM}; pg8::SchedStd S; S.so.init(T, DFF, G, c);
            pg8::EpiUp E{hbuf}; pg8::gemm_phase(lds, g, S, E); }
        SEAM(p0 + 6);
        if (IN(p0 + 7)) { PHASE_PTRS(l) pg8::Gemm g{hbuf, (const bf16_t*)(ws + WS_WDN) + (size_t)lq * DM * DFF, DFF, DFF, DFF}; pg8::SchedStd S; S.so.init(T, DM, G, c);
            pg8::EpiResid E{xb, ss + (2 * lq + 2) * T, lq == NLAYER - 1 ? ap->out : nullptr, ss + (2 * lq + 1) * T}; pg8::gemm_phase(lds, g, S, E); }
        if (l + 1 < NLAYER) SEAM(p0 + 7);
    }
#undef IN
#undef SEAM
}

#ifndef MK_N_LAUNCHES
#define MK_N_LAUNCHES 1
#endif
extern "C" void kernel_launch(void* const* d_in, const int* in_sizes, int n_in, void* d_out, int out_size, void* d_ws, size_t ws_size, hipStream_t stream) {
    static int grid = 0;
    if (grid == 0) {
        if (n_in != 21 || ws_size < WS_END) { fprintf(stderr, "kernel_launch: unexpected n_in %d / ws_size %zu\n", n_in, ws_size); grid = -1; return; }
        int dev = 0, cus = 0, per_cu = 0;
        hipGetDevice(&dev); hipDeviceGetAttribute(&cus, hipDeviceAttributeMultiprocessorCount, dev);
        if (hipFuncSetAttribute((const void*)fwd_megakernel, hipFuncAttributeMaxDynamicSharedMemorySize, LDS_BYTES) != hipSuccess) { fprintf(stderr, "kernel_launch: hipFuncSetAttribute failed\n"); grid = -1; return; }
        if (hipOccupancyMaxActiveBlocksPerMultiprocessor(&per_cu, (const void*)fwd_megakernel, 512, LDS_BYTES) != hipSuccess || per_cu < 1) { fprintf(stderr, "kernel_launch: occupancy query says %d\n", per_cu); per_cu = 1; }
        (void)hipGetLastError();
        grid = cus * 1;
    }
    if (grid < 0) return;
    if (hipMemsetAsync((char*)d_ws + WS_BAR, 0, 16384, stream) != hipSuccess) { fprintf(stderr, "kernel_launch: memset failed\n"); return; }
    Args a{};
    for (int i = 0; i < 21; ++i) a.in[i] = (const float*)d_in[i];
    a.out = (float*)d_out; a.ws = (unsigned char*)d_ws;
#if MK_N_LAUNCHES == 1
    a.ph_lo = 0; a.ph_hi = NPHASE;
    void* kargs[] = {&a};
    hipError_t e = hipLaunchCooperativeKernel((const void*)fwd_megakernel, dim3(grid), dim3(512), kargs, LDS_BYTES, stream);
    if (e != hipSuccess) fprintf(stderr, "cooperative launch failed: %s (grid %d)\n", hipGetErrorString(e), grid);
#else
    for (int p = 0; p < NPHASE; ++p) { a.ph_lo = p; a.ph_hi = p + 1; hipLaunchKernelGGL(fwd_megakernel, dim3(grid), dim3(512), LDS_BYTES, stream, a); }
#endif
}
```
